# Optimizing an MI355X kernel written in HIP

```python
import math
import jax, jax.numpy as jnp
from jax import lax
import numpy as np

D_MODEL = 2048
BATCH = 16
SEQ = 2048
DEPTH = 1
DEC_BATCH = 4
DEC_SEQ = 4096
PAST_LEN = 128

HEAD_DIM = 128
HEADS_PER_GROUP = 4
DILATED_GROUPS = ((128, 1), (512, 4), (2048, 16))
N_GROUPS = len(DILATED_GROUPS)
N_ATTN_HEADS = N_GROUPS * HEADS_PER_GROUP
ATTN_W = N_ATTN_HEADS * HEAD_DIM
ATTN_OUT_W = HEADS_PER_GROUP * HEAD_DIM
NUM_BUCKETS = 32
REL_MAX_DIST = 1024
LRU_W = 1536
LRU_BLOCKS = 12
LRU_BLOCK_W = LRU_W // LRU_BLOCKS
LRU_C = 8.0
CONV_W = 4
D_FF = 4 * D_MODEL
NORM_EPS = 1e-6
NEG_INF = -1e30
D_IN = 3 * ATTN_W + 2 * LRU_W + 2 * D_MODEL
SPLIT_POINTS = (ATTN_W, 2 * ATTN_W, 3 * ATTN_W, 3 * ATTN_W + LRU_W,
                3 * ATTN_W + 2 * LRU_W, 3 * ATTN_W + 2 * LRU_W + D_MODEL)

kernel_name = "hybrid_dilated_attn_rglru_encoder"


def _rmsnorm(x, g):
    xf = x.astype(jnp.float32)
    y = xf * lax.rsqrt(jnp.mean(xf * xf, axis=-1, keepdims=True) + NORM_EPS)
    return (y * g.astype(jnp.float32)).astype(x.dtype)


def _t5_bucket(rel):
    half = NUM_BUCKETS // 2
    max_exact = half // 2
    n = jnp.abs(rel)
    nf = jnp.maximum(n, 1).astype(jnp.float32)
    large = max_exact + (jnp.log(nf / max_exact) / math.log(REL_MAX_DIST / max_exact)
                         * (half - max_exact)).astype(jnp.int32)
    large = jnp.minimum(large, half - 1)
    return jnp.where(rel > 0, half, 0) + jnp.where(n < max_exact, n, large)


def _dilated_group(q, k, v, bias_tab, window, dil):
    B, S, H, hd = q.shape
    L = S // dil
    C = window // (2 * dil)
    N = B * dil

    def fold(t):
        return t.reshape(B, L, dil, H, hd).transpose(0, 2, 1, 3, 4).reshape(N, L, H, hd)

    q, k, v = fold(q), fold(k), fold(v)
    nb = -(-L // C)
    Lp = nb * C
    qb = jnp.pad(q, ((0, 0), (0, Lp - L), (0, 0), (0, 0))).reshape(N, nb, C, H, hd)

    def band(t):
        tp = jnp.pad(t, ((0, 0), (C, Lp - L + C), (0, 0), (0, 0))).reshape(N, nb + 2, C, H, hd)
        return jnp.concatenate([tp[:, :-2], tp[:, 1:-1], tp[:, 2:]], axis=2)

    kb, vb = band(k), band(v)
    s = jnp.einsum('nbqhd,nbkhd->nbhqk', qb, kb).astype(jnp.float32) * (HEAD_DIM ** -0.5)
    qi = jnp.arange(C, dtype=jnp.int32)[:, None]
    ki = jnp.arange(3 * C, dtype=jnp.int32)[None, :] - C
    rel = ki - qi
    key_idx = jnp.arange(nb, dtype=jnp.int32)[:, None, None] * C + ki[None]
    valid = (jnp.abs(rel) <= C)[None] & (key_idx >= 0) & (key_idx < L)
    bias = bias_tab.astype(jnp.float32)[_t5_bucket(rel * dil)].transpose(2, 0, 1)
    s = jnp.where(valid[None, :, None], s + bias[None, None], NEG_INF)
    m = jnp.max(s, axis=-1)
    p = jnp.exp(s - m[..., None])
    l = jnp.sum(p, axis=-1)
    o = jnp.einsum('nbhqk,nbkhd->nbqhd', p, vb.astype(jnp.float32))
    o = o / l.transpose(0, 1, 3, 2)[..., None]
    lse = (m + jnp.log(l)).transpose(0, 1, 3, 2)
    o = o.reshape(N, Lp, H, hd)[:, :L]
    lse = lse.reshape(N, Lp, H)[:, :L]
    o = o.reshape(B, dil, L, H, hd).transpose(0, 2, 1, 3, 4).reshape(B, S, H, hd)
    lse = lse.reshape(B, dil, L, H).transpose(0, 2, 1, 3).reshape(B, S, H)
    return o, lse


def _centred_conv(x, w, b):
    S = x.shape[1]
    left = CONV_W // 2
    xp = jnp.pad(x, ((0, 0), (left, CONV_W - 1 - left), (0, 0)))
    y = b
    for t in range(CONV_W):
        y = y + xp[:, t:t + S] * w[t]
    return y


def _block_diag(x, w, b):
    B, S, _ = x.shape
    xb = x.reshape(B, S, LRU_BLOCKS, LRU_BLOCK_W)
    return jnp.einsum('bsni,nij->bsnj', xb, w.astype(jnp.float32)).reshape(B, S, LRU_W) + b.astype(jnp.float32)


def _lin_combine(e1, e2):
    a1, b1 = e1
    a2, b2 = e2
    return a1 * a2, a2 * b1 + b2


def _rglru(x, wa, ba, wx, bx, lam):
    r = jax.nn.sigmoid(_block_diag(x, wa, ba))
    i = jax.nn.sigmoid(_block_diag(x, wx, bx))
    log_a = -LRU_C * r * jax.nn.softplus(-lam.astype(jnp.float32))
    a = jnp.exp(log_a)
    u = jnp.sqrt(-jnp.expm1(2.0 * log_a)) * (i * x)
    _, h = lax.associative_scan(_lin_combine, (a, u), axis=1)
    return h


def _mixer(u, rel_bias, w_in, conv_w, conv_b, lru_wa, lru_ba, lru_wx, lru_bx, lru_lambda,
           w_attn_o, w_rnn_o, w_out):
    B, S, _ = u.shape
    z = u @ w_in
    q, k, v, rx, ry, g_attn, g_rnn = jnp.split(z, SPLIT_POINTS, axis=-1)
    q = q.reshape(B, S, N_ATTN_HEADS, HEAD_DIM)
    k = k.reshape(B, S, N_ATTN_HEADS, HEAD_DIM)
    v = v.reshape(B, S, N_ATTN_HEADS, HEAD_DIM)
    outs, lses = [], []
    for g, (window, dil) in enumerate(DILATED_GROUPS):
        hs = slice(g * HEADS_PER_GROUP, (g + 1) * HEADS_PER_GROUP)
        o, lse = _dilated_group(q[:, :, hs], k[:, :, hs], v[:, :, hs], rel_bias[:, hs], window, dil)
        outs.append(o)
        lses.append(lse)
    wts = jax.nn.softmax(jnp.stack(lses), axis=0)
    attn = jnp.sum(wts[..., None] * jnp.stack(outs), axis=0).reshape(B, S, ATTN_OUT_W).astype(u.dtype)

    xc = _centred_conv(rx.astype(jnp.float32), conv_w.astype(jnp.float32), conv_b.astype(jnp.float32))
    h_fwd = _rglru(xc, lru_wa[0], lru_ba[0], lru_wx[0], lru_bx[0], lru_lambda[0])
    h_bwd = jnp.flip(_rglru(jnp.flip(xc, axis=1), lru_wa[1], lru_ba[1], lru_wx[1], lru_bx[1],
                            lru_lambda[1]), axis=1)
    rnn = ((h_fwd + h_bwd) * jax.nn.gelu(ry.astype(jnp.float32))).astype(u.dtype)

    merged = jax.nn.sigmoid(g_attn) * (attn @ w_attn_o) + jax.nn.sigmoid(g_rnn) * (rnn @ w_rnn_o)
    return merged @ w_out


def _mlp(u, w1, w2):
    return jnp.square(jax.nn.relu(u @ w1)) @ w2


def setup_inputs(seed: int = 0) -> dict:
    key = jax.random.key(seed)
    ks = jax.random.split(key, 24)
    f32 = jnp.float32
    nrm = lambda k, shape, scale: jax.random.normal(k, shape, f32) * scale
    u = jax.random.uniform(ks[12], (DEPTH, 2, LRU_W), f32, minval=0.9, maxval=0.999)
    a0 = u ** (1.0 / LRU_C)
    lru_lambda = jnp.log(a0) - jnp.log1p(-a0)
    return {
        "x_prompt": nrm(ks[0], (BATCH, SEQ, D_MODEL), 1.0),
        "x_sample": nrm(ks[1], (DEC_BATCH, DEC_SEQ, D_MODEL), 1.0),
        "rel_bias": nrm(ks[2], (NUM_BUCKETS, N_ATTN_HEADS), 0.5),
        "norm_mix_g": 1.0 + nrm(ks[3], (DEPTH, D_MODEL), 0.05),
        "w_in": nrm(ks[4], (DEPTH, D_MODEL, D_IN), D_MODEL ** -0.5),
        "conv_w": nrm(ks[5], (DEPTH, CONV_W, LRU_W), 0.5),
        "conv_b": nrm(ks[6], (DEPTH, LRU_W), 0.05),
        "lru_wa": nrm(ks[7], (DEPTH, 2, LRU_BLOCKS, LRU_BLOCK_W, LRU_BLOCK_W), LRU_BLOCK_W ** -0.5),
        "lru_ba": nrm(ks[8], (DEPTH, 2, LRU_W), 0.1),
        "lru_wx": nrm(ks[9], (DEPTH, 2, LRU_BLOCKS, LRU_BLOCK_W, LRU_BLOCK_W), LRU_BLOCK_W ** -0.5),
        "lru_bx": nrm(ks[10], (DEPTH, 2, LRU_W), 0.1),
        "lru_lambda": lru_lambda,
        "w_attn_o": nrm(ks[13], (DEPTH, ATTN_OUT_W, D_MODEL), ATTN_OUT_W ** -0.5),
        "w_rnn_o": nrm(ks[14], (DEPTH, LRU_W, D_MODEL), LRU_W ** -0.5),
        "w_out": nrm(ks[15], (DEPTH, D_MODEL, D_MODEL), D_MODEL ** -0.5),
        "norm_mlp_g": 1.0 + nrm(ks[16], (DEPTH, D_MODEL), 0.05),
        "w_mlp_in": nrm(ks[17], (DEPTH, D_MODEL, D_FF), D_MODEL ** -0.5),
        "w_mlp_out": nrm(ks[18], (DEPTH, D_FF, D_MODEL), D_FF ** -0.5),
        "norm_final_g": 1.0 + nrm(ks[19], (D_MODEL,), 0.05),
    }


def reference(x_prompt, x_sample, rel_bias, norm_mix_g, w_in, conv_w, conv_b, lru_wa, lru_ba,
              lru_wx, lru_bx, lru_lambda, w_attn_o, w_rnn_o, w_out, norm_mlp_g, w_mlp_in,
              w_mlp_out, norm_final_g):
    def trunk(x):
        for l in range(DEPTH):
            x = x + _mixer(_rmsnorm(x, norm_mix_g[l]), rel_bias, w_in[l], conv_w[l], conv_b[l],
                           lru_wa[l], lru_ba[l], lru_wx[l], lru_bx[l], lru_lambda[l],
                           w_attn_o[l], w_rnn_o[l], w_out[l])
            x = x + _mlp(_rmsnorm(x, norm_mlp_g[l]), w_mlp_in[l], w_mlp_out[l])
        return _rmsnorm(x, norm_final_g)

    y_prompt = trunk(x_prompt)
    y_sample = trunk(x_sample)
    return (y_prompt, y_sample)
```

```cpp
#include <hip/hip_runtime.h>
#include <hip/hip_cooperative_groups.h>
#include <cstdio>
#include <cstdint>
namespace cg = cooperative_groups;

#ifndef MK_MULTI
#define MK_MULTI 0
#endif

constexpr int DM = 2048, CH = 16384, NCH = 3;
constexpr int DIN = 11776;
constexpr int C_Q = 0, C_K = 1536, C_V = 3072, C_RX = 4608, C_RY = 6144, C_GA = 7680, C_GR = 9728;
constexpr int DFF = 8192, AW = 512, LW = 1536;
constexpr float NORM_EPS = 1e-6f;
constexpr float LOG2E = 1.4426950408889634f;
constexpr float QSCALE = 0.08838834764831845f * 1.4426950408889634f;

namespace pg8 {
#define PG8_LAS __attribute__((address_space(3)))
typedef unsigned short bf16_t;
typedef short bf16x8 __attribute__((ext_vector_type(8)));
typedef float f32x4 __attribute__((ext_vector_type(4)));
typedef unsigned u32x4 __attribute__((ext_vector_type(4)));
constexpr int BM = 256, BK = 64, HALF = 128, HTB = HALF * BK * 2  , STAGE_BYTES = 8 * HTB, NXCD = 8, WGM = 8;

__host__ __device__ __forceinline__ int lds_byte(int r, int c) { const int st = (r >> 4) * 2 + (c >> 5), rr = r & 15, cc = c & 31, ob = rr * 64 + cc * 2; return st * 1024 + (ob ^ (((ob >> 9) & 1) << 5)); }
__host__ __device__ __forceinline__ void stage_rc(int b, int& R, int& C) { const int st = b / 1024, sb = b % 1024, swz = sb ^ (((sb >> 9) & 1) << 5); R = (st >> 1) * 16 + swz / 64; C = (st & 1) * 32 + (swz % 64) / 2; }
__host__ __device__ __forceinline__ int perm32(int rho) { const int n = rho >> 4, i = rho & 15; return 8 * (i >> 2) + 4 * n + (i & 3); }

struct Unit { int pm, pn; };
struct Gemm { const bf16_t* A; const bf16_t* Bt; int M, N, K; };

struct StaticOrder {
    int nM, nN, nwg, G, c;
    __host__ __device__ void init(int M, int N, int G_, int c_) { nM = M / BM; nN = N / BM; nwg = nM * nN; G = G_; c = c_; }
    __host__ __device__ bool next(int i, Unit& u) const {
        const long L = (long)i * G + c; if (L >= nwg) return false;
        int wgid = (int)L; { const int q = nwg / NXCD, r = nwg % NXCD, xcd = wgid % NXCD, off = wgid / NXCD; wgid = (xcd < r ? xcd * (q + 1) : r * (q + 1) + (xcd - r) * q) + off; }
        const int nig = WGM * nN, gid = wgid / nig, fm = gid * WGM, gsz = (nM - fm) < WGM ? (nM - fm) : WGM;
        u.pm = fm + ((wgid % nig) % gsz); u.pn = (wgid % nig) / gsz; return true;
    }
    __device__ __forceinline__ void a_ready(const Unit&) const {}
    __device__ __forceinline__ void done(const Unit&) const {}
};

__device__ __forceinline__ unsigned cvt_pk_bf16(float lo, float hi) { unsigned r; asm volatile("v_cvt_pk_bf16_f32 %0, %1, %2" : "=v"(r) : "v"(lo), "v"(hi)); return r; }
typedef float f32x2 __attribute__((ext_vector_type(2)));
typedef unsigned u32x2 __attribute__((ext_vector_type(2)));
__device__ __forceinline__ float sigmoidf_fast(float x) { return __builtin_amdgcn_rcpf(1.0f + __builtin_amdgcn_exp2f(-1.4426950408889634f * x)); }
__device__ __forceinline__ float bf_lo(unsigned w) { return __uint_as_float(w << 16); }
__device__ __forceinline__ float bf_hi(unsigned w) { return __uint_as_float(w & 0xffff0000u); }

struct EpiZ {
    static constexpr bool PERM = true, AFTER_DRAIN = false;
    bf16_t* Z;
    __device__ __forceinline__ void operator()(const f32x4 (&acc)[2][2][4][2], const Unit& u, int wr, int wc, int fr, int fq) const {
        const int row0 = u.pm * BM + wr * 64 + fr, col0 = u.pn * BM + wc * 32 + 8 * fq;
        const int mode = u.pn < 6 ? 1 : (u.pn >= 30 ? 2 : 0);
#pragma unroll
        for (int ai = 0; ai < 2; ++ai)
#pragma unroll
            for (int m = 0; m < 4; ++m) { bf16_t* rowp = Z + (size_t)(row0 + ai * HALF + m * 16) * DIN + col0;
#pragma unroll
                for (int bj = 0; bj < 2; ++bj) { f32x4 v0 = acc[ai][bj][m][0], v1 = acc[ai][bj][m][1];
                    if (mode == 1) { v0 = v0 * QSCALE; v1 = v1 * QSCALE; }
                    else if (mode == 2) {
#pragma unroll
                        for (int e = 0; e < 4; ++e) { v0[e] = sigmoidf_fast(v0[e]); v1[e] = sigmoidf_fast(v1[e]); } }
                    u32x4 w; w.x = cvt_pk_bf16(v0[0], v0[1]); w.y = cvt_pk_bf16(v0[2], v0[3]); w.z = cvt_pk_bf16(v1[0], v1[1]); w.w = cvt_pk_bf16(v1[2], v1[3]);
                    *(u32x4*)(rowp + bj * HALF) = w; } }
    }
};
template <bool SECOND> struct EpiGate {
    static constexpr bool PERM = true, AFTER_DRAIN = false;
    const bf16_t* Zg; bf16_t* MG;
    __device__ __forceinline__ void operator()(const f32x4 (&acc)[2][2][4][2], const Unit& u, int wr, int wc, int fr, int fq) const {
        const int row0 = u.pm * BM + wr * 64 + fr, col0 = u.pn * BM + wc * 32 + 8 * fq;
#pragma unroll
        for (int ai = 0; ai < 2; ++ai)
#pragma unroll
            for (int m = 0; m < 4; ++m) { const size_t row = (size_t)(row0 + ai * HALF + m * 16);
#pragma unroll
                for (int bj = 0; bj < 2; ++bj) { const int col = col0 + bj * HALF;
                    const u32x4 gw = *(const u32x4*)(Zg + row * DIN + col);
                    f32x4 g0 = (f32x4){bf_lo(gw.x), bf_hi(gw.x), bf_lo(gw.y), bf_hi(gw.y)}, g1 = (f32x4){bf_lo(gw.z), bf_hi(gw.z), bf_lo(gw.w), bf_hi(gw.w)};
                    f32x4 v0 = acc[ai][bj][m][0] * g0, v1 = acc[ai][bj][m][1] * g1;
                    bf16_t* mp = MG + row * DM + col;
                    if (SECOND) { const u32x4 pw = *(const u32x4*)mp;
                        v0 = v0 + (f32x4){bf_lo(pw.x), bf_hi(pw.x), bf_lo(pw.y), bf_hi(pw.y)}; v1 = v1 + (f32x4){bf_lo(pw.z), bf_hi(pw.z), bf_lo(pw.w), bf_hi(pw.w)}; }
                    u32x4 w; w.x = cvt_pk_bf16(v0[0], v0[1]); w.y = cvt_pk_bf16(v0[2], v0[3]); w.z = cvt_pk_bf16(v1[0], v1[1]); w.w = cvt_pk_bf16(v1[2], v1[3]);
                    *(u32x4*)mp = w; }
                asm volatile("" ::: "memory"); }
    }
};
struct EpiX1 {
    static constexpr bool PERM = true, AFTER_DRAIN = false;
    const float* base; bf16_t* XN; float* SS;
    __device__ __forceinline__ void operator()(const f32x4 (&acc)[2][2][4][2], const Unit& u, int wr, int wc, int fr, int fq) const {
        const int row0 = u.pm * BM + wr * 64 + fr, col0 = u.pn * BM + wc * 32 + 8 * fq;
#pragma unroll
        for (int ai = 0; ai < 2; ++ai)
#pragma unroll
            for (int m = 0; m < 4; ++m) { const size_t row = (size_t)(row0 + ai * HALF + m * 16); float ss = 0.f;
#pragma unroll
                for (int bj = 0; bj < 2; ++bj) { const size_t off = row * DM + col0 + bj * HALF;
                    f32x4 v0 = acc[ai][bj][m][0] + *(const f32x4*)(base + off), v1 = acc[ai][bj][m][1] + *(const f32x4*)(base + off + 4);
                    u32x4 w; w.x = cvt_pk_bf16(v0[0], v0[1]); w.y = cvt_pk_bf16(v0[2], v0[3]); w.z = cvt_pk_bf16(v1[0], v1[1]); w.w = cvt_pk_bf16(v1[2], v1[3]);
                    *(u32x4*)(XN + off) = w;
                    v0 = (f32x4){bf_lo(w.x), bf_hi(w.x), bf_lo(w.y), bf_hi(w.y)}; v1 = (f32x4){bf_lo(w.z), bf_hi(w.z), bf_lo(w.w), bf_hi(w.w)};
                    ss += (v0[0] * v0[0] + v0[1] * v0[1]) + (v0[2] * v0[2] + v0[3] * v0[3]) + (v1[0] * v1[0] + v1[1] * v1[1]) + (v1[2] * v1[2] + v1[3] * v1[3]); }
                ss += __shfl_xor(ss, 16); ss += __shfl_xor(ss, 32);
                if (fq == 0) SS[row * 32 + u.pn * 4 + wc] = ss; }
    }
};
struct EpiX2 {
    static constexpr bool PERM = true, AFTER_DRAIN = false;
    const bf16_t* XN; float* out; float* SS;
    __device__ __forceinline__ void operator()(const f32x4 (&acc)[2][2][4][2], const Unit& u, int wr, int wc, int fr, int fq) const {
        const int row0 = u.pm * BM + wr * 64 + fr, col0 = u.pn * BM + wc * 32 + 8 * fq;
#pragma unroll
        for (int ai = 0; ai < 2; ++ai)
#pragma unroll
            for (int m = 0; m < 4; ++m) { const size_t row = (size_t)(row0 + ai * HALF + m * 16); float ss = 0.f;
#pragma unroll
                for (int bj = 0; bj < 2; ++bj) { const size_t off = row * DM + col0 + bj * HALF;
                    const u32x4 pw = *(const u32x4*)(XN + off);
                    const f32x4 v0 = acc[ai][bj][m][0] + (f32x4){bf_lo(pw.x), bf_hi(pw.x), bf_lo(pw.y), bf_hi(pw.y)}, v1 = acc[ai][bj][m][1] + (f32x4){bf_lo(pw.z), bf_hi(pw.z), bf_lo(pw.w), bf_hi(pw.w)};
                    *(f32x4*)(out + off) = v0; *(f32x4*)(out + off + 4) = v1;
                    ss += (v0[0] * v0[0] + v0[1] * v0[1]) + (v0[2] * v0[2] + v0[3] * v0[3]) + (v1[0] * v1[0] + v1[1] * v1[1]) + (v1[2] * v1[2] + v1[3] * v1[3]); }
                ss += __shfl_xor(ss, 16); ss += __shfl_xor(ss, 32);
                if (fq == 0) SS[row * 32 + u.pn * 4 + wc] = ss; }
    }
};
struct EpiMlpUp {
    static constexpr bool PERM = true, AFTER_DRAIN = false;
    const float* SS; bf16_t* H;
    __device__ __forceinline__ void operator()(const f32x4 (&acc)[2][2][4][2], const Unit& u, int wr, int wc, int fr, int fq) const {
        const int row0 = u.pm * BM + wr * 64 + fr, col0 = u.pn * BM + wc * 32 + 8 * fq;
#pragma unroll
        for (int ai = 0; ai < 2; ++ai)
#pragma unroll
            for (int m = 0; m < 4; ++m) { const size_t row = (size_t)(row0 + ai * HALF + m * 16);
                const f32x4* sp = (const f32x4*)(SS + row * 32); float s = 0.f;
#pragma unroll
                for (int i = 0; i < 8; ++i) { const f32x4 t = sp[i]; s += (t[0] + t[1]) + (t[2] + t[3]); }
                const float rstd = 1.0f / sqrtf(s * (1.0f / DM) + NORM_EPS);
#pragma unroll
                for (int bj = 0; bj < 2; ++bj) { f32x4 v0 = acc[ai][bj][m][0] * rstd, v1 = acc[ai][bj][m][1] * rstd;
#pragma unroll
                    for (int e = 0; e < 4; ++e) { const float a = fmaxf(v0[e], 0.f), b = fmaxf(v1[e], 0.f); v0[e] = a * a; v1[e] = b * b; }
                    u32x4 w; w.x = cvt_pk_bf16(v0[0], v0[1]); w.y = cvt_pk_bf16(v0[2], v0[3]); w.z = cvt_pk_bf16(v1[0], v1[1]); w.w = cvt_pk_bf16(v1[2], v1[3]);
                    *(u32x4*)(H + row * DFF + col0 + bj * HALF) = w; } }
    }
};

template <class Epi, class Sched, bool ALIGN_EPI = false, bool SP2 = false>
__device__ __forceinline__ void gemm_phase(PG8_LAS unsigned char* lds, const Gemm g, const Sched& S, const Epi& E) {
    int tid_ = threadIdx.x; asm volatile("" : "+v"(tid_));
    const int tid = tid_, wid = __builtin_amdgcn_readfirstlane(tid >> 6), lane = tid & 63, wr = wid >> 2, wc = wid & 3, fr = lane & 15, fq = lane >> 4;
    const int K = g.K, nt = K / BK;
    unsigned voffA[2], voffB[2];
#pragma unroll
    for (int i = 0; i < 2; ++i) { int R, C; stage_rc(tid * 16 + i * 8192, R, C); const int Rb = Epi::PERM ? ((R & ~31) + perm32(R & 31)) : R;
        voffA[i] = (unsigned)(R * K + C) * 2u; voffB[i] = (unsigned)(Rb * K + C) * 2u; }
    const size_t kstep = (size_t)(BK * 2);
    const size_t hstep = (size_t)HALF * K * 2;
    const size_t tstep = 2 * hstep;
    const unsigned ldsw = (unsigned)wid * 1024u;
    const int aoff = lds_byte(wr * 64 + fr, fq * 8), boff = lds_byte(wc * 32 + fr, fq * 8);
#define PG8_SA(b, h) (((b) * 2 + (h)) * HTB)
#define PG8_SB(b, h) ((4 + (b) * 2 + (h)) * HTB)
#define PG8_STAGE(bufoff, gbase, voff) do { _Pragma("unroll") for (int _i = 0; _i < 2; ++_i) \
        __builtin_amdgcn_global_load_lds((const unsigned*)((const char*)(gbase) + (voff)[_i]), (PG8_LAS unsigned*)(lds + (bufoff) + ldsw + _i * 8192), 16, 0, 0); } while (0)
#define PG8_LDA(dst, b, h) do { _Pragma("unroll") for (int m = 0; m < 4; ++m) _Pragma("unroll") for (int k = 0; k < 2; ++k) dst[m][k] = *(const PG8_LAS bf16x8*)(lds + PG8_SA(b, h) + aoff + m * 2048 + k * 1024); } while (0)
#define PG8_LDB(dst, b, h) do { _Pragma("unroll") for (int n = 0; n < 2; ++n) _Pragma("unroll") for (int k = 0; k < 2; ++k) dst[n][k] = *(const PG8_LAS bf16x8*)(lds + PG8_SB(b, h) + boff + n * 2048 + k * 1024); } while (0)
#define PG8_MMA(ai, bj, At, Bt) do { __builtin_amdgcn_s_setprio(1); _Pragma("unroll") for (int m = 0; m < 4; ++m) _Pragma("unroll") for (int n = 0; n < 2; ++n) _Pragma("unroll") for (int k = 0; k < 2; ++k) \
        acc[ai][bj][m][n] = __builtin_amdgcn_mfma_f32_16x16x32_bf16(Bt[n][k], At[m][k], acc[ai][bj][m][n], 0, 0, 0); __builtin_amdgcn_s_setprio(0); } while (0)
#define PG8_WAIT_V(n) asm volatile("s_waitcnt vmcnt(" #n ")" ::: "memory")
#define PG8_WAIT_L(n) asm volatile("s_waitcnt lgkmcnt(" #n ")" ::: "memory")
#define PG8_BAR __builtin_amdgcn_s_barrier()
#define PG8_SCHED __builtin_amdgcn_sched_barrier(0)
    Unit cur, nxt; int ui = 0;
    if (!S.next(0, cur)) return;
    f32x4 acc[2][2][4][2];
#pragma unroll
    for (int a = 0; a < 2; ++a)
#pragma unroll
        for (int b = 0; b < 2; ++b)
#pragma unroll
            for (int m = 0; m < 4; ++m)
#pragma unroll
                for (int n = 0; n < 2; ++n) acc[a][b][m][n] = (f32x4){0.f, 0.f, 0.f, 0.f};
    bf16x8 At[4][2], B0[2][2], B1[2][2];
    const char* cA = (const char*)g.A + (size_t)cur.pm * tstep; const char* cB = (const char*)g.Bt + (size_t)cur.pn * tstep;
    S.a_ready(cur);
    if constexpr (SP2) {
        PG8_STAGE(PG8_SB(0, 0), cB, voffB); PG8_STAGE(PG8_SB(0, 1), cB + hstep, voffB); PG8_STAGE(PG8_SA(0, 0), cA, voffA); PG8_STAGE(PG8_SA(0, 1), cA + hstep, voffA);
        if (wr == 1) PG8_BAR;
        PG8_WAIT_V(2); PG8_BAR;
        PG8_STAGE(PG8_SB(1, 0), cB + kstep, voffB); PG8_STAGE(PG8_SA(1, 0), cA + kstep, voffA); PG8_STAGE(PG8_SB(1, 1), cB + hstep + kstep, voffB);
        PG8_WAIT_V(6); PG8_BAR;
    } else {
        PG8_STAGE(PG8_SB(0, 0), cB, voffB); PG8_STAGE(PG8_SA(0, 0), cA, voffA); PG8_STAGE(PG8_SB(0, 1), cB + hstep, voffB); PG8_STAGE(PG8_SA(0, 1), cA + hstep, voffA);
        if (wr == 1) PG8_BAR;
        PG8_WAIT_V(4); PG8_BAR;
        PG8_STAGE(PG8_SB(1, 0), cB + kstep, voffB); PG8_STAGE(PG8_SA(1, 0), cA + kstep, voffA); PG8_STAGE(PG8_SB(1, 1), cB + hstep + kstep, voffB);
        PG8_WAIT_V(6); PG8_BAR;
    }
    for (;;) {
        const bool has_next = S.next(ui + 1, nxt);
        const char* nA = has_next ? (const char*)g.A + (size_t)nxt.pm * tstep : cA; const char* nB = has_next ? (const char*)g.Bt + (size_t)nxt.pn * tstep : cB;
        for (int t = 0; t < nt; t += 2) {
            const bool last = (t == nt - 2);
            const char* a1 = cA + (size_t)(t + 1) * kstep;
            const char* a2 = last ? nA : cA + (size_t)(t + 2) * kstep; const char* b2 = last ? nB : cB + (size_t)(t + 2) * kstep;
            const char* a3 = a2 + kstep; const char* b3 = b2 + kstep;
            if (last && has_next) S.a_ready(nxt);
            if constexpr (SP2) {
            PG8_LDB(B0, 0, 0); PG8_LDB(B1, 0, 1); PG8_SCHED; PG8_LDA(At, 0, 0); PG8_STAGE(PG8_SA(1, 1), a1 + hstep, voffA);
            PG8_WAIT_V(8); PG8_WAIT_L(0); PG8_BAR; PG8_MMA(0, 0, At, B0); PG8_MMA(0, 1, At, B1); PG8_BAR; PG8_SCHED;
            PG8_LDA(At, 0, 1); PG8_STAGE(PG8_SB(0, 0), b2, voffB); PG8_STAGE(PG8_SB(0, 1), b2 + hstep, voffB); PG8_STAGE(PG8_SA(0, 0), a2, voffA);
            PG8_WAIT_V(8); PG8_WAIT_L(0); PG8_BAR; PG8_MMA(1, 0, At, B0); PG8_MMA(1, 1, At, B1); PG8_BAR; PG8_SCHED;
            PG8_LDB(B0, 1, 0); PG8_LDB(B1, 1, 1); PG8_SCHED; PG8_LDA(At, 1, 0); PG8_STAGE(PG8_SA(0, 1), a2 + hstep, voffA);
            PG8_WAIT_V(8); PG8_WAIT_L(0); PG8_BAR; PG8_MMA(0, 0, At, B0); PG8_MMA(0, 1, At, B1); PG8_BAR; PG8_SCHED;
            PG8_LDA(At, 1, 1); PG8_STAGE(PG8_SB(1, 0), b3, voffB); PG8_STAGE(PG8_SB(1, 1), b3 + hstep, voffB); PG8_STAGE(PG8_SA(1, 0), a3, voffA);
            PG8_WAIT_V(8); PG8_WAIT_L(0); PG8_BAR; PG8_MMA(1, 0, At, B0); PG8_MMA(1, 1, At, B1); PG8_BAR; PG8_SCHED;
            } else {
            PG8_LDB(B0, 0, 0); PG8_SCHED; PG8_LDA(At, 0, 0); PG8_STAGE(PG8_SA(1, 1), a1 + hstep, voffA);
            PG8_WAIT_L(8); PG8_BAR; PG8_WAIT_L(0); PG8_MMA(0, 0, At, B0); PG8_BAR; PG8_SCHED;
            PG8_LDB(B1, 0, 1); PG8_STAGE(PG8_SB(0, 0), b2, voffB);
            PG8_BAR; PG8_WAIT_L(0); PG8_MMA(0, 1, At, B1); PG8_BAR;
            PG8_LDA(At, 0, 1); PG8_STAGE(PG8_SA(0, 0), a2, voffA);
            PG8_BAR; PG8_WAIT_L(0); PG8_MMA(1, 0, At, B0); PG8_BAR; PG8_SCHED;
            PG8_STAGE(PG8_SB(0, 1), b2 + hstep, voffB);
            PG8_WAIT_V(6); PG8_BAR; PG8_MMA(1, 1, At, B1); PG8_BAR;
            PG8_LDB(B0, 1, 0); PG8_SCHED; PG8_LDA(At, 1, 0); PG8_STAGE(PG8_SA(0, 1), a2 + hstep, voffA);
            PG8_WAIT_L(8); PG8_BAR; PG8_WAIT_L(0); PG8_MMA(0, 0, At, B0); PG8_BAR; PG8_SCHED;
            PG8_LDB(B1, 1, 1); PG8_STAGE(PG8_SB(1, 0), b3, voffB);
            PG8_BAR; PG8_WAIT_L(0); PG8_MMA(0, 1, At, B1); PG8_BAR;
            PG8_LDA(At, 1, 1); PG8_STAGE(PG8_SA(1, 0), a3, voffA);
            PG8_BAR; PG8_WAIT_L(0); PG8_MMA(1, 0, At, B0); PG8_BAR; PG8_SCHED;
            PG8_STAGE(PG8_SB(1, 1), b3 + hstep, voffB);
            PG8_WAIT_V(6); PG8_BAR; PG8_MMA(1, 1, At, B1); PG8_BAR;
            }
        }
        if constexpr (ALIGN_EPI) { if (wr == 0) PG8_BAR; }
        if constexpr (!Epi::AFTER_DRAIN) { E(acc, cur, wr, wc, fr, fq); S.done(cur); }
        if (!has_next) break;
#pragma unroll
        for (int a = 0; a < 2; ++a)
#pragma unroll
            for (int b = 0; b < 2; ++b)
#pragma unroll
                for (int m = 0; m < 4; ++m)
#pragma unroll
                    for (int n = 0; n < 2; ++n) acc[a][b][m][n] = (f32x4){0.f, 0.f, 0.f, 0.f};
        cur = nxt; cA = nA; cB = nB; ++ui;
        if constexpr (ALIGN_EPI) { if (wr == 1) PG8_BAR; }
    }
    PG8_WAIT_V(0);
    if constexpr (!ALIGN_EPI) { if (wr == 0) PG8_BAR; }
    PG8_BAR;
    if constexpr (Epi::AFTER_DRAIN) { E.fused(acc, cur, wr, wc, fr, fq, lds, wid, lane); S.done(cur); }
#undef PG8_SA
#undef PG8_SB
#undef PG8_STAGE
#undef PG8_LDA
#undef PG8_LDB
#undef PG8_MMA
#undef PG8_WAIT_V
#undef PG8_WAIT_L
#undef PG8_BAR
#undef PG8_SCHED
}
}

constexpr size_t MiB = (size_t)1 << 20;
constexpr size_t WS_CTL = 0;
constexpr size_t WS_WIN = 1 * MiB;
constexpr size_t WS_WAO = 47 * MiB;
constexpr size_t WS_WRO = 49 * MiB;
constexpr size_t WS_WOUT = 55 * MiB;
constexpr size_t WS_W1 = 63 * MiB;
constexpr size_t WS_W2 = 95 * MiB;
constexpr size_t WS_WL = 127 * MiB;
constexpr size_t WS_SS = 129 * MiB;
constexpr size_t WS_LSUM = 131 * MiB;
constexpr size_t WS_LCAR = 137 * MiB;
constexpr size_t WS_LSE = 140 * MiB;
constexpr size_t WS_XN = 141 * MiB;
constexpr size_t WS_ATT = 205 * MiB;
constexpr size_t WS_RNN = 221 * MiB;
constexpr size_t WS_OG = 269 * MiB;
constexpr size_t WS_MG = 317 * MiB;
constexpr size_t WS_MG1 = 381 * MiB;
constexpr size_t WS_Z = 509 * MiB;
constexpr size_t WS_END = 877 * MiB;

constexpr int LDS_BYTES = 131072 + 1024;
constexpr int NPH = 9;
constexpr int NPHASES = 1 + NCH * NPH;

#define LAS __attribute__((address_space(3)))
typedef unsigned short bf16_t;
typedef short bf16x8 __attribute__((ext_vector_type(8)));
typedef short s16x4 __attribute__((ext_vector_type(4)));
typedef float f32x4 __attribute__((ext_vector_type(4)));
typedef unsigned u32x4 __attribute__((ext_vector_type(4)));
typedef unsigned u32x2 __attribute__((ext_vector_type(2)));
#define LDS_WAIT() asm volatile("s_waitcnt lgkmcnt(0)" ::: "memory")

__device__ __forceinline__ unsigned pk2(float lo, float hi) { return pg8::cvt_pk_bf16(lo, hi); }
__device__ __forceinline__ float bflo(unsigned w) { return __uint_as_float(w << 16); }
__device__ __forceinline__ float bfhi(unsigned w) { return __uint_as_float(w & 0xffff0000u); }
__device__ __forceinline__ float wave_sum(float v) {
#pragma unroll
    for (int o = 1; o < 64; o <<= 1) v += __shfl_xor(v, o);
    return v;
}
__device__ __forceinline__ float fast_sigmoid(float x) { return __builtin_amdgcn_rcpf(1.0f + __builtin_amdgcn_exp2f(-LOG2E * x)); }
__device__ __forceinline__ unsigned off_b(unsigned row, unsigned ch) { return 256u * row + 16u * (ch ^ (((row & 3u) << 2) | ((row >> 2) & 3u))); }
__device__ __forceinline__ s16x4 ldtr(LAS const unsigned char* p) { return __builtin_bit_cast(s16x4, __builtin_amdgcn_ds_read_tr16_b64_v4i16((LAS s16x4*)p)); }
template <int CTRL> __device__ __forceinline__ float dpp_f(float old, float v) {
    return __int_as_float(__builtin_amdgcn_update_dpp(__float_as_int(old), __float_as_int(v), CTRL, 0xf, 0xf, false));
}

struct Args { const float* in[19]; float* out; unsigned char* ws; int ph_lo, ph_hi; };
__device__ __forceinline__ unsigned long long ldsptr(LAS unsigned char* lds, int i) {
    const LAS unsigned* p = (const LAS unsigned*)(lds + 131072 + 8 * i);
    const unsigned lo = __builtin_amdgcn_readfirstlane(p[0]), hi = __builtin_amdgcn_readfirstlane(p[1]);
    return ((unsigned long long)hi << 32) | lo;
}
#define GAS __attribute__((address_space(1)))
#define ARGP(i) ((const float*)(GAS const float*)ldsptr(lds, (i)))

#define XB_TMO      128
#define XB_XCNT(j)  (256  + 64 * (j))
#define XB_XSUB(j)  (1280 + 64 * (j))
#define XB_XGEN(j)  (2304 + 64 * (j))
#define XB_TOP      3328
#define XB_TOPGEN   3392
#define XCD_BAR_WORDS 3456
#define XB_SPIN_CAP (1u << 18)

__device__ __forceinline__ unsigned xb_ld(unsigned* p)              { return __hip_atomic_load(p, __ATOMIC_RELAXED, __HIP_MEMORY_SCOPE_AGENT); }
__device__ __forceinline__ unsigned xb_add(unsigned* p, unsigned v) { return __hip_atomic_fetch_add(p, v, __ATOMIC_RELAXED, __HIP_MEMORY_SCOPE_AGENT); }
__device__ __forceinline__ unsigned xb_xcc_id() { return (unsigned)__builtin_amdgcn_s_getreg((3 << 11) | 20) & 0xFu; }
#define XB_SPIN(cond, bar) do { unsigned _sp = 0; while (cond) { __builtin_amdgcn_s_sleep(1); \
    if ((++_sp & 255u) == 0u) { if (xb_ld(&(bar)[XB_TMO])) break; if (_sp > XB_SPIN_CAP) { atomicAdd(&(bar)[XB_TMO], 1u); break; } } } } while (0)

struct XcdBarrier {
    unsigned* bar; unsigned x;
    volatile LAS unsigned* st;
};

__device__ __forceinline__ XcdBarrier xcd_barrier_post(unsigned* bar, volatile LAS unsigned* st) {
    XcdBarrier b; b.bar = bar; b.x = xb_xcc_id(); b.st = st;
    if (threadIdx.x == 0) (void)xb_add(&bar[XB_XCNT(b.x)], 1u);
    return b;
}
__device__ __forceinline__ void xcd_barrier_complete(unsigned* bar, unsigned x, unsigned& nloc, unsigned& nx) {
    const unsigned G = gridDim.x * gridDim.y * gridDim.z;
    unsigned sum, cnt, mine, sp = 0u;
    for (;;) {
        sum = 0u; cnt = 0u; mine = 0u;
#pragma unroll
        for (unsigned j = 0; j < 16; ++j) { const unsigned c = xb_ld(&bar[XB_XCNT(j)]); sum += c; cnt += (c > 0u) ? 1u : 0u; mine = (j == x) ? c : mine; }
        if (sum == G) break;
        __builtin_amdgcn_s_sleep(1);
        if ((++sp & 255u) == 0u) { if (xb_ld(&bar[XB_TMO])) break; if (sp > XB_SPIN_CAP) { atomicAdd(&bar[XB_TMO], 1u); break; } }
    }
    nloc = mine > 0u ? mine : 1u; nx = cnt > 0u ? cnt : 1u;
}

__device__ __forceinline__ void xcd_barrier(const XcdBarrier& b) {
    asm volatile("s_waitcnt vmcnt(0)" ::: "memory");
    __syncthreads();
    if (threadIdx.x == 0) {
        unsigned* bar = b.bar;
        __builtin_amdgcn_s_waitcnt(0);
        unsigned nloc = b.st[0], nx = b.st[1];
        if (nloc == 0u) { xcd_barrier_complete(bar, b.x, nloc, nx); b.st[0] = nloc; b.st[1] = nx; }
        const unsigned old = xb_add(&bar[XB_XSUB(b.x)], 1u);
        const unsigned gen = old / nloc;
        if (old + 1u == (gen + 1u) * nloc) {
            __builtin_amdgcn_fence(__ATOMIC_RELEASE, "agent");
            asm volatile("s_waitcnt vmcnt(0)" ::: "memory");
            const unsigned og = xb_add(&bar[XB_TOP], 1u);
            const unsigned tg = og / nx;
            if (og + 1u == (tg + 1u) * nx) xb_add(&bar[XB_TOPGEN], 1u);
            else XB_SPIN(xb_ld(&bar[XB_TOPGEN]) == tg, bar);
            __builtin_amdgcn_fence(__ATOMIC_ACQUIRE, "agent");
            xb_add(&bar[XB_XGEN(b.x)], 1u);
            asm volatile("s_waitcnt vmcnt(0)" ::: "memory");
        } else {
            XB_SPIN(xb_ld(&bar[XB_XGEN(b.x)]) == gen, bar);
            __builtin_amdgcn_fence(__ATOMIC_ACQUIRE, "agent");
            asm volatile("s_waitcnt vmcnt(0)" ::: "memory");
        }
    }
    __syncthreads();
}

__device__ __forceinline__ void transpose_item(const float* W, int K, int N, bf16_t* WT, const float* ksc, LAS float* scr, int item, int lane) {
    const int nblk = N / 32, kb = item / nblk, nb = item % nblk, k0 = 64 * kb, n0 = 32 * nb;
#pragma unroll 8
    for (int i = 0; i < 32; ++i) { const int kk = 2 * i + (lane >> 5); float v = W[(size_t)(k0 + kk) * N + n0 + (lane & 31)]; if (ksc) v *= ksc[k0 + kk]; scr[kk * 33 + (lane & 31)] = v; }
    LDS_WAIT(); asm volatile("" ::: "memory");
    const int c = lane & 7;
#pragma unroll
    for (int j = 0; j < 4; ++j) { const int n = (lane >> 3) + 8 * j; const LAS float* s = scr + (8 * c) * 33 + n;
        u32x4 o; o.x = pk2(s[0 * 33], s[1 * 33]); o.y = pk2(s[2 * 33], s[3 * 33]); o.z = pk2(s[4 * 33], s[5 * 33]); o.w = pk2(s[6 * 33], s[7 * 33]);
        *(u32x4*)(WT + (size_t)(n0 + n) * K + k0 + 8 * c) = o; }
    LDS_WAIT(); asm volatile("" ::: "memory");
}
__device__ __forceinline__ void phase_weights(LAS unsigned char* lds, unsigned char* ws, int gw, int NGW, int wave, int lane) {
    LAS float* scr = (LAS float*)(lds + wave * 16384);
    constexpr int I_IN = (DM / 64) * (DIN / 32), I_AO = (AW / 64) * (DM / 32), I_RO = (LW / 64) * (DM / 32), I_OUT = (DM / 64) * (DM / 32),
                  I_1 = (DM / 64) * (DFF / 32), I_2 = (DFF / 64) * (DM / 32), I_L = 48 * 8;
    constexpr int NITEMS = I_IN + I_AO + I_RO + I_OUT + I_1 + I_2 + I_L;
    for (int it = gw; it < NITEMS; it += NGW) {
        int r = it;
        if (r < I_IN) { transpose_item(ARGP(4), DM, DIN, (bf16_t*)(ws + WS_WIN), nullptr, scr, r, lane); continue; } r -= I_IN;
        if (r < I_AO) { transpose_item(ARGP(12), AW, DM, (bf16_t*)(ws + WS_WAO), nullptr, scr, r, lane); continue; } r -= I_AO;
        if (r < I_RO) { transpose_item(ARGP(13), LW, DM, (bf16_t*)(ws + WS_WRO), nullptr, scr, r, lane); continue; } r -= I_RO;
        if (r < I_OUT) { transpose_item(ARGP(14), DM, DM, (bf16_t*)(ws + WS_WOUT), nullptr, scr, r, lane); continue; } r -= I_OUT;
        if (r < I_1) { transpose_item(ARGP(16), DM, DFF, (bf16_t*)(ws + WS_W1), ARGP(15), scr, r, lane); continue; } r -= I_1;
        if (r < I_2) { transpose_item(ARGP(17), DFF, DM, (bf16_t*)(ws + WS_W2), nullptr, scr, r, lane); continue; } r -= I_2;
        {
            const int mi = r >> 3, sub = r & 7, q = mi / 12, n = mi % 12, dir = q >> 1, type = q & 1;
            const float* src = (type ? ARGP(9) : ARGP(7)) + (size_t)(dir * 12 + n) * 128 * 128;
            transpose_item(src, 128, 128, (bf16_t*)(ws + WS_WL) + (size_t)(n * 4 + q) * 128 * 128, nullptr, scr, sub, lane);
        }
    }
}
__device__ __forceinline__ void phase_xnorm(const float* x, const float* gain, bf16_t* XN, int gw, int NGW, int lane) {
    for (int m = gw; m < CH; m += NGW) {
        const f32x4* xr = (const f32x4*)(x + (size_t)m * DM) + lane;
        f32x4 v[8]; float s = 0.f;
#pragma unroll
        for (int j = 0; j < 8; ++j) { v[j] = xr[64 * j]; s += (v[j][0] * v[j][0] + v[j][1] * v[j][1]) + (v[j][2] * v[j][2] + v[j][3] * v[j][3]); }
        const float rstd = 1.0f / sqrtf(wave_sum(s) * (1.0f / DM) + NORM_EPS);
        u32x2* o = (u32x2*)(XN + (size_t)m * DM) + lane;
#pragma unroll
        for (int j = 0; j < 8; ++j) { const f32x4 g = ((const f32x4*)gain)[64 * j + lane]; const f32x4 y = v[j] * rstd * g;
            u32x2 w; w.x = pk2(y[0], y[1]); w.y = pk2(y[2], y[3]); o[64 * j] = w; }
    }
}
__device__ __forceinline__ void phase_final_norm(float* out, const float* SS, const float* gain, int gw, int NGW, int lane) {
    for (int m = gw; m < CH; m += NGW) {
        const float p = lane < 32 ? SS[(size_t)m * 32 + lane] : 0.f;
        const float rstd = 1.0f / sqrtf(wave_sum(p) * (1.0f / DM) + NORM_EPS);
        f32x4* xr = (f32x4*)(out + (size_t)m * DM) + lane;
#pragma unroll
        for (int j = 0; j < 8; ++j) { const f32x4 g = ((const f32x4*)gain)[64 * j + lane]; xr[64 * j] = xr[64 * j] * rstd * g; }
    }
}

__device__ __forceinline__ void phase_attn(LAS unsigned char* lds, const bf16_t* Z, const float* rel_bias, bf16_t* OG, float* LSE, int S, int tid, int lane, int wave, int G) {
    LAS float* tab = (LAS float*)lds;
    for (int e = tid; e < 12 * 192; e += 512) {
        const int hh = e / 192, ri = e % 192, rel = ri - 95, gg = hh >> 2, dist = rel * (1 << (2 * gg));
        const int n = dist < 0 ? -dist : dist; const float nf = (float)(n < 1 ? 1 : n);
        int large = 8 + (int)(logf(nf / 8.0f) / logf(128.0f) * 8.0f); large = large < 15 ? large : 15;
        const int bucket = (dist > 0 ? 16 : 0) + (n < 8 ? n : large);
        tab[e] = (rel >= -64 && rel <= 64) ? rel_bias[bucket * 12 + hh] * LOG2E : -1e30f;
    }
    __syncthreads();
    const int gw = blockIdx.x * 8 + wave, NGW = G * 8;
    const int c = lane & 15, g4 = lane >> 4, tq = c >> 2, tp = c & 3;
    LAS unsigned char* vt = lds + 16384 + wave * 8192;
    constexpr int PER_GRP = CH / 8;
    for (int item = gw; item < 3 * PER_GRP; item += NGW) {
        const int grp = item / PER_GRP; int idx = item % PER_GRP;
        const int sh = 2 * grp, L = S >> sh, nqb = L >> 5;
        const int qb = idx % nqb; idx /= nqb; const int h = idx & 3; idx >>= 2; const int r = idx & ((1 << sh) - 1); const int b = idx >> sh;
        const int head = grp * 4 + h, i0 = qb * 32;
        const size_t rowbase = (size_t)b * S + r;
        const bf16_t* Zq = Z + C_Q + head * 128; const bf16_t* Zk = Z + C_K + head * 128; const bf16_t* Zv = Z + C_V + head * 128;
        bf16x8 qf[2][4];
#pragma unroll
        for (int qt = 0; qt < 2; ++qt)
#pragma unroll
            for (int s = 0; s < 4; ++s) qf[qt][s] = *(const bf16x8*)(Zq + (rowbase + ((size_t)(i0 + 16 * qt + c) << sh)) * DIN + 32 * s + 8 * g4);
        f32x4 sa[2][10];
        bf16x8 kf[4], kg[4];
#define ATT_LOADK(dst, KT) { int fi = i0 - 64 + 16 * (KT) + c; fi = fi < 0 ? 0 : (fi > L - 1 ? L - 1 : fi); \
            const bf16_t* kp = Zk + (rowbase + ((size_t)fi << sh)) * DIN + 8 * g4; \
            _Pragma("unroll") for (int s = 0; s < 4; ++s) dst[s] = *(const bf16x8*)(kp + 32 * s); }
        ATT_LOADK(kf, 0) ATT_LOADK(kg, 1)
#pragma unroll
        for (int kt = 0; kt < 10; ++kt) {
            bf16x8 kn[4];
            if (kt + 2 < 10) ATT_LOADK(kn, kt + 2)
#pragma unroll
            for (int qt = 0; qt < 2; ++qt) { f32x4 acc = (f32x4){0.f, 0.f, 0.f, 0.f};
#pragma unroll
                for (int s = 0; s < 4; ++s) acc = __builtin_amdgcn_mfma_f32_16x16x32_bf16(kf[s], qf[qt][s], acc, 0, 0, 0);
                sa[qt][kt] = acc; }
#pragma unroll
            for (int s = 0; s < 4; ++s) { kf[s] = kg[s]; if (kt + 2 < 10) kg[s] = kn[s]; }
            __builtin_amdgcn_sched_barrier(0);
        }
#undef ATT_LOADK
        u32x4 vr[8];
#pragma unroll
        for (int i = 0; i < 8; ++i) { int fi = i0 - 64 + g4 + 4 * i; fi = fi < 0 ? 0 : (fi > L - 1 ? L - 1 : fi);
            vr[i] = *(const u32x4*)(Zv + (rowbase + ((size_t)fi << sh)) * DIN + 8 * c); }
        const LAS float* tb = tab + head * 192 + 95 - 64 - c;
        const bool edge = (i0 < 64) || (i0 + 96 > L);
        float mx[2], ls[2];
#pragma unroll
        for (int qt = 0; qt < 2; ++qt) {
            float m = -1e30f;
#pragma unroll
            for (int kt = 0; kt < 10; ++kt) {
                const f32x4 bv = *(const LAS f32x4*)(tb + 16 * kt + 4 * g4 - 16 * qt);
                sa[qt][kt] = sa[qt][kt] + bv; }
            if (edge) {
#pragma unroll
                for (int kt = 0; kt < 10; ++kt)
#pragma unroll
                    for (int j = 0; j < 4; ++j) { const int fi = i0 - 64 + 16 * kt + 4 * g4 + j; if (fi < 0 || fi >= L) sa[qt][kt][j] = -1e30f; }
            }
#pragma unroll
            for (int kt = 0; kt < 10; ++kt) m = fmaxf(fmaxf(m, fmaxf(sa[qt][kt][0], sa[qt][kt][1])), fmaxf(sa[qt][kt][2], sa[qt][kt][3]));
            m = fmaxf(m, __shfl_xor(m, 16)); m = fmaxf(m, __shfl_xor(m, 32)); mx[qt] = m;
            float sum = 0.f;
#pragma unroll
            for (int kt = 0; kt < 10; ++kt)
#pragma unroll
                for (int j = 0; j < 4; ++j) { const float p = __builtin_amdgcn_exp2f(sa[qt][kt][j] - m); sa[qt][kt][j] = p; sum += p; }
            sum += __shfl_xor(sum, 16); sum += __shfl_xor(sum, 32); ls[qt] = sum;
            __builtin_amdgcn_sched_barrier(0);
        }
        bf16x8 pf[2][5];
#pragma unroll
        for (int qt = 0; qt < 2; ++qt)
#pragma unroll
            for (int ks = 0; ks < 5; ++ks) { const f32x4 p0 = sa[qt][2 * ks], p1 = sa[qt][2 * ks + 1];
                u32x4 w; w.x = pk2(p0[0], p0[1]); w.y = pk2(p0[2], p0[3]); w.z = pk2(p1[0], p1[1]); w.w = pk2(p1[2], p1[3]);
                pf[qt][ks] = __builtin_bit_cast(bf16x8, w); }
        f32x4 oa[2][8];
#pragma unroll
        for (int qt = 0; qt < 2; ++qt)
#pragma unroll
            for (int cc = 0; cc < 8; ++cc) oa[qt][cc] = (f32x4){0.f, 0.f, 0.f, 0.f};
#pragma unroll
        for (int ks = 0; ks < 5; ++ks) {
#pragma unroll
            for (int i = 0; i < 8; ++i) *(LAS u32x4*)(vt + off_b(g4 + 4 * i, c)) = vr[i];
            if (ks + 1 < 5) {
#pragma unroll
                for (int i = 0; i < 8; ++i) { int fi = i0 - 64 + 32 * (ks + 1) + g4 + 4 * i; fi = fi < 0 ? 0 : (fi > L - 1 ? L - 1 : fi);
                    vr[i] = *(const u32x4*)(Zv + (rowbase + ((size_t)fi << sh)) * DIN + 8 * c); } }
#pragma unroll
            for (int cc = 0; cc < 8; ++cc) {
                const s16x4 lo = ldtr(vt + off_b(4 * g4 + tq, 2 * cc + (tp >> 1)) + 8 * (tp & 1));
                const s16x4 hi = ldtr(vt + off_b(16 + 4 * g4 + tq, 2 * cc + (tp >> 1)) + 8 * (tp & 1));
                const bf16x8 vf = (bf16x8){lo[0], lo[1], lo[2], lo[3], hi[0], hi[1], hi[2], hi[3]};
#pragma unroll
                for (int qt = 0; qt < 2; ++qt) oa[qt][cc] = __builtin_amdgcn_mfma_f32_16x16x32_bf16(vf, pf[qt][ks], oa[qt][cc], 0, 0, 0);
            }
            __builtin_amdgcn_sched_barrier(0);
        }
#pragma unroll
        for (int qt = 0; qt < 2; ++qt) {
            const float inv = 1.0f / ls[qt];
            const size_t row = rowbase + ((size_t)(i0 + 16 * qt + c) << sh);
            bf16_t* op = OG + ((size_t)grp * CH + row) * AW + h * 128 + 4 * g4;
#pragma unroll
            for (int cc = 0; cc < 8; ++cc) { const f32x4 o = oa[qt][cc] * inv; u32x2 w; w.x = pk2(o[0], o[1]); w.y = pk2(o[2], o[3]); *(u32x2*)(op + 16 * cc) = w; }
            if (g4 == 0) LSE[((size_t)grp * CH + row) * 4 + h] = mx[qt] + log2f(ls[qt]);
        }
    }
}
__device__ __forceinline__ void phase_combine(const bf16_t* OG, const float* LSE, bf16_t* ATT, int tid, int G) {
    for (size_t idx = (size_t)blockIdx.x * 512 + tid; idx < (size_t)CH * 64; idx += (size_t)G * 512) {
        const size_t row = idx >> 6; const int ck = (int)(idx & 63), h = ck >> 4;
        const float l0 = LSE[(row) * 4 + h], l1 = LSE[((size_t)CH + row) * 4 + h], l2 = LSE[((size_t)2 * CH + row) * 4 + h];
        const float M = fmaxf(l0, fmaxf(l1, l2));
        float w0 = __builtin_amdgcn_exp2f(l0 - M), w1 = __builtin_amdgcn_exp2f(l1 - M), w2 = __builtin_amdgcn_exp2f(l2 - M);
        const float inv = 1.0f / (w0 + w1 + w2); w0 *= inv; w1 *= inv; w2 *= inv;
        const u32x4 a = *(const u32x4*)(OG + row * AW + ck * 8), b = *(const u32x4*)(OG + ((size_t)CH + row) * AW + ck * 8), d = *(const u32x4*)(OG + ((size_t)2 * CH + row) * AW + ck * 8);
        u32x4 o;
#pragma unroll
        for (int e = 0; e < 4; ++e) { const float lo = w0 * bflo(a[e]) + w1 * bflo(b[e]) + w2 * bflo(d[e]), hi = w0 * bfhi(a[e]) + w1 * bfhi(b[e]) + w2 * bfhi(d[e]); o[e] = pk2(lo, hi); }
        *(u32x4*)(ATT + row * AW + ck * 8) = o;
    }
}

constexpr int LRU_RAW = 0, LRU_RAWP = 272, LRU_XC = 18432, LRU_KC = 36864;
template <int PASS> __device__ __forceinline__ void phase_lru(LAS unsigned char* lds, const bf16_t* Z, const bf16_t* WL, float* LSUM, const float* LCAR, bf16_t* RNN,
                                                              int S, int tid, int lane, int wave, int G) {
    const int c = lane & 15, g4 = lane >> 4;
    const float* conv_w = ARGP(5); const float* conv_b = ARGP(6); const float* lba = ARGP(8); const float* lbx = ARGP(10); const float* lam = ARGP(11);
    for (int item = blockIdx.x; item < 12 * 64; item += G) {
        const int n = item >> 6, run = item & 63;
        const int ch0 = n * 128 + wave * 16 + 4 * g4;
        bf16x8 wf[4][4];
#pragma unroll
        for (int q = 0; q < 4; ++q)
#pragma unroll
            for (int s = 0; s < 4; ++s) wf[q][s] = *(const bf16x8*)(WL + ((size_t)((n * 4 + q) * 128 + wave * 16 + c)) * 128 + 32 * s + 8 * g4);
        LAS f32x4* kc = (LAS f32x4*)(lds + LRU_KC + wave * 11264);
#pragma unroll
        for (int k = 0; k < 4; ++k) kc[(6 + k) * 64 + lane] = *(const f32x4*)(conv_w + k * LW + ch0);
        kc[10 * 64 + lane] = *(const f32x4*)(conv_b + ch0);
#pragma unroll
        for (int d = 0; d < 2; ++d) { kc[(3 * d + 0) * 64 + lane] = *(const f32x4*)(lba + d * LW + ch0); kc[(3 * d + 1) * 64 + lane] = *(const f32x4*)(lbx + d * LW + ch0);
            const f32x4 lv = *(const f32x4*)(lam + d * LW + ch0); f32x4 sp;
#pragma unroll
            for (int j = 0; j < 4; ++j) sp[j] = 8.0f * LOG2E * log1pf(expf(-lv[j]));
            kc[(3 * d + 2) * 64 + lane] = sp; }
#define LRU_BAR() do { asm volatile("s_waitcnt lgkmcnt(0)" ::: "memory"); __builtin_amdgcn_s_barrier(); asm volatile("" ::: "memory"); } while (0)
        u32x4 rawr[3];
#define LRU_LOAD_RAW(SEG) { const int t0_ = (SEG) * 64, spos_ = t0_ & (S - 1); \
            _Pragma("unroll") for (int i = 0; i < 3; ++i) { const int idx = tid + 512 * i, rr = idx >> 4, chk = idx & 15, sp_ = spos_ - 2 + rr; \
                rawr[i] = (u32x4){0u, 0u, 0u, 0u}; \
                if (idx < 67 * 16 && sp_ >= 0 && sp_ < S) rawr[i] = *(const u32x4*)(Z + (size_t)(t0_ - 2 + rr) * DIN + C_RX + n * 128 + 8 * chk); } }
        LRU_LOAD_RAW(run * 4)
        for (int sg = 0; sg < 4; ++sg) {
            const int seg = run * 4 + sg, t0 = seg * 64;
#pragma unroll
            for (int i = 0; i < 3; ++i) { const int idx = tid + 512 * i; if (idx < 67 * 16) *(LAS u32x4*)(lds + LRU_RAW + (idx >> 4) * LRU_RAWP + 16 * (idx & 15)) = rawr[i]; }
            u32x2 ryr[4]; f32x4 car[2];
            if (PASS == 1) {
#pragma unroll
                for (int t = 0; t < 4; ++t) ryr[t] = *(const u32x2*)(Z + (size_t)(t0 + 16 * t + c) * DIN + C_RY + ch0);
                car[0] = *(const f32x4*)(LCAR + (size_t)(seg * 2 + 0) * LW + ch0); car[1] = *(const f32x4*)(LCAR + (size_t)(seg * 2 + 1) * LW + ch0);
            }
            LRU_BAR();
            f32x4 cw[4], cb;
#pragma unroll
            for (int k = 0; k < 4; ++k) cw[k] = kc[(6 + k) * 64 + lane];
            cb = kc[10 * 64 + lane];
            f32x4 xc[4];
#pragma unroll
            for (int t = 0; t < 4; ++t) { f32x4 acc = cb;
#pragma unroll
                for (int k = 0; k < 4; ++k) { const u32x2 rw = *(const LAS u32x2*)(lds + LRU_RAW + (16 * t + c + k) * LRU_RAWP + (wave * 16 + 4 * g4) * 2);
                    acc = acc + (f32x4){bflo(rw.x), bfhi(rw.x), bflo(rw.y), bfhi(rw.y)} * cw[k]; }
                xc[t] = acc;
                u32x2 w; w.x = pk2(acc[0], acc[1]); w.y = pk2(acc[2], acc[3]);
                *(LAS u32x2*)(lds + LRU_XC + off_b(16 * t + c, 2 * wave + (g4 >> 1)) + 8 * (g4 & 1)) = w; }
            LRU_BAR();
            if (sg + 1 < 4) LRU_LOAD_RAW(seg + 1)
            f32x4 hf[4];
            {
                f32x4 Hc = (f32x4){0.f, 0.f, 0.f, 0.f}, Ac = (f32x4){1.f, 1.f, 1.f, 1.f};
                if (PASS == 1) Hc = car[0];
#pragma unroll
                for (int t = 0; t < 4; ++t) {
                    f32x4 gr = (f32x4){0.f, 0.f, 0.f, 0.f}, gi = gr;
#pragma unroll
                    for (int s = 0; s < 4; ++s) { const bf16x8 bfr = *(const LAS bf16x8*)(lds + LRU_XC + off_b(16 * t + c, 4 * s + g4));
                        gr = __builtin_amdgcn_mfma_f32_16x16x32_bf16(wf[0][s], bfr, gr, 0, 0, 0); gi = __builtin_amdgcn_mfma_f32_16x16x32_bf16(wf[1][s], bfr, gi, 0, 0, 0); }
                    const f32x4 kba = kc[0 * 64 + lane], kbx = kc[1 * 64 + lane], ksp = kc[2 * 64 + lane];
#pragma unroll
                    for (int j = 0; j < 4; ++j) {
                        const float rg = fast_sigmoid(gr[j] + kba[j]), ig = fast_sigmoid(gi[j] + kbx[j]);
                        float av = __builtin_amdgcn_exp2f(-rg * ksp[j]);
                        float hv = __builtin_amdgcn_sqrtf(fmaxf(1.0f - av * av, 0.f)) * (ig * xc[t][j]);
#define LRU_STEP_F(sft) { const float ap = dpp_f<0x110 + sft>(1.0f, av), hp = dpp_f<0x110 + sft>(0.0f, hv); hv = fmaf(av, hp, hv); av = av * ap; }
                        LRU_STEP_F(1) LRU_STEP_F(2) LRU_STEP_F(4) LRU_STEP_F(8)
#undef LRU_STEP_F
                        const float hfull = fmaf(av, Hc[j], hv);
                        if (PASS == 1) hf[t][j] = hfull;
                        Hc[j] = __shfl(hfull, (lane & 48) | 15);
                        if (PASS == 0) Ac[j] *= __shfl(av, (lane & 48) | 15);
                    }
                    __builtin_amdgcn_sched_barrier(0);
                }
                if (PASS == 0 && c == 0) {
#pragma unroll
                    for (int j = 0; j < 4; ++j) { float* sp = LSUM + ((size_t)(seg * 2 + 0) * LW + ch0 + j) * 2; sp[0] = Ac[j]; sp[1] = Hc[j]; }
                }
            }
            {
                f32x4 Hc = (f32x4){0.f, 0.f, 0.f, 0.f}, Ac = (f32x4){1.f, 1.f, 1.f, 1.f};
                if (PASS == 1) Hc = car[1];
#pragma unroll
                for (int tt = 0; tt < 4; ++tt) { const int t = 3 - tt;
                    f32x4 gr = (f32x4){0.f, 0.f, 0.f, 0.f}, gi = gr;
#pragma unroll
                    for (int s = 0; s < 4; ++s) { const bf16x8 bfr = *(const LAS bf16x8*)(lds + LRU_XC + off_b(16 * t + c, 4 * s + g4));
                        gr = __builtin_amdgcn_mfma_f32_16x16x32_bf16(wf[2][s], bfr, gr, 0, 0, 0); gi = __builtin_amdgcn_mfma_f32_16x16x32_bf16(wf[3][s], bfr, gi, 0, 0, 0); }
                    f32x4 ov;
                    const f32x4 kba = kc[3 * 64 + lane], kbx = kc[4 * 64 + lane], ksp = kc[5 * 64 + lane];
#pragma unroll
                    for (int j = 0; j < 4; ++j) {
                        const float rg = fast_sigmoid(gr[j] + kba[j]), ig = fast_sigmoid(gi[j] + kbx[j]);
                        float av = __builtin_amdgcn_exp2f(-rg * ksp[j]);
                        float hv = __builtin_amdgcn_sqrtf(fmaxf(1.0f - av * av, 0.f)) * (ig * xc[t][j]);
#define LRU_STEP_B(sft) { const float ap = dpp_f<0x100 + sft>(1.0f, av), hp = dpp_f<0x100 + sft>(0.0f, hv); hv = fmaf(av, hp, hv); av = av * ap; }
                        LRU_STEP_B(1) LRU_STEP_B(2) LRU_STEP_B(4) LRU_STEP_B(8)
#undef LRU_STEP_B
                        const float hfull = fmaf(av, Hc[j], hv);
                        Hc[j] = __shfl(hfull, lane & 48);
                        if (PASS == 0) Ac[j] *= __shfl(av, lane & 48);
                        if (PASS == 1) { const unsigned rw = j < 2 ? ryr[t].x : ryr[t].y; const float y = (j & 1) ? bfhi(rw) : bflo(rw);
                            const float ge = y * __builtin_amdgcn_rcpf(1.0f + __builtin_amdgcn_exp2f(-2.3022082f * (y + 0.044715f * y * y * y)));
                            ov[j] = (hf[t][j] + hfull) * ge; }
                    }
                    if (PASS == 1) { u32x2 w; w.x = pk2(ov[0], ov[1]); w.y = pk2(ov[2], ov[3]); *(u32x2*)(RNN + (size_t)(t0 + 16 * t + c) * LW + ch0) = w; }
                    __builtin_amdgcn_sched_barrier(0);
                }
                if (PASS == 0 && c == 0) {
#pragma unroll
                    for (int j = 0; j < 4; ++j) { float* sp = LSUM + ((size_t)(seg * 2 + 1) * LW + ch0 + j) * 2; sp[0] = Ac[j]; sp[1] = Hc[j]; }
                }
            }
        }
#undef LRU_LOAD_RAW
#undef LRU_BAR
        __syncthreads();
    }
}
__device__ __forceinline__ void phase_lru_carry(const float* LSUM, float* LCAR, int S, int tid, int G) {
    const int nseq = CH / S, nseg = S / 64;
    for (int idx = blockIdx.x * 512 + tid; idx < nseq * 2 * LW; idx += G * 512) {
        const int ch = idx % LW, dir = (idx / LW) & 1, b = idx / (2 * LW);
        float H = 0.f;
        for (int i0 = 0; i0 < nseg; i0 += 8) {
            float A[8], h[8];
#pragma unroll
            for (int u = 0; u < 8; ++u) { const int i = i0 + u, s = dir ? nseg - 1 - i : i; const size_t o = (size_t)((b * nseg + s) * 2 + dir) * LW + ch;
                const float2 v = *(const float2*)(LSUM + o * 2); A[u] = v.x; h[u] = v.y; }
#pragma unroll
            for (int u = 0; u < 8; ++u) { const int i = i0 + u, s = dir ? nseg - 1 - i : i; const size_t o = (size_t)((b * nseg + s) * 2 + dir) * LW + ch;
                LCAR[o] = H; H = fmaf(A[u], H, h[u]); }
        }
    }
}

#ifndef REP_MASK
#define REP_MASK 0
#endif
#ifndef ONLY_K
#define EN(k) true
#else
#define EN(k) ((k) == ONLY_K)
#endif
__global__ void __launch_bounds__(512, 2) fwd_kernel(Args args) {
    extern __shared__ __attribute__((aligned(16))) unsigned char lds_raw[];
    LAS unsigned char* lds = (LAS unsigned char*)lds_raw;
    {
        LAS unsigned long long* pt = (LAS unsigned long long*)(lds + 131072);
        if (threadIdx.x == 0) {
#pragma unroll
            for (int i = 0; i < 19; ++i) pt[i] = (unsigned long long)args.in[i];
            pt[19] = (unsigned long long)args.out; pt[20] = (unsigned long long)args.ws;
        }
        if (threadIdx.x == 32) { ((LAS unsigned*)(lds + 131072 + 512))[0] = 0u; ((LAS unsigned*)(lds + 131072 + 512))[1] = 0u; }
        __syncthreads();
    }
    cg::grid_group grid = cg::this_grid();
    XcdBarrier xbar = xcd_barrier_post((unsigned*)(GAS unsigned*)args.ws + 1024, (volatile LAS unsigned*)(lds + 131072 + 512));
    bool first_sync = true;
#define GRID_BAR() do { __syncthreads(); if (first_sync) { grid.sync(); first_sync = false; } else xcd_barrier(xbar); } while (0)

    const int ph_hi = args.ph_hi;
    for (int q = 2 * args.ph_lo; q < 2 * ph_hi; ++q) {
        const int p = q >> 1;
        if (REP_MASK == 0 && (q & 1)) continue;
        if (REP_MASK != 0 && (q & 1) && !((REP_MASK >> (p == 0 ? 9 : (p - 1) % NPH)) & 1)) { if (p + 1 < ph_hi) GRID_BAR(); continue; }
        int tid = threadIdx.x; asm volatile("" : "+v"(tid));
        const int lane = tid & 63, wave = __builtin_amdgcn_readfirstlane(tid >> 6);
        const int G = gridDim.x, gw = blockIdx.x * 8 + wave, NGW = G * 8;
        unsigned char* ws = (unsigned char*)(GAS unsigned char*)ldsptr(lds, 20);
        bf16_t* const WIN = (bf16_t*)(ws + WS_WIN); bf16_t* const WAO = (bf16_t*)(ws + WS_WAO); bf16_t* const WRO = (bf16_t*)(ws + WS_WRO); bf16_t* const WOUT = (bf16_t*)(ws + WS_WOUT);
        bf16_t* const W1 = (bf16_t*)(ws + WS_W1); bf16_t* const W2 = (bf16_t*)(ws + WS_W2); bf16_t* const WL = (bf16_t*)(ws + WS_WL);
        float* const SS = (float*)(ws + WS_SS); float* const LSUM = (float*)(ws + WS_LSUM); float* const LCAR = (float*)(ws + WS_LCAR); float* const LSE = (float*)(ws + WS_LSE);
        bf16_t* const XN = (bf16_t*)(ws + WS_XN); bf16_t* const ATT = (bf16_t*)(ws + WS_ATT); bf16_t* const RNN = (bf16_t*)(ws + WS_RNN); bf16_t* const OG = (bf16_t*)(ws + WS_OG);
        bf16_t* const MG = (bf16_t*)(ws + WS_MG); float* const MG1 = (float*)(ws + WS_MG1); bf16_t* const Z = (bf16_t*)(ws + WS_Z); bf16_t* const HB = (bf16_t*)(ws + WS_Z);
        if (EN(9) && p == 0) {
            phase_weights(lds, ws, gw, NGW, wave, lane);
            phase_xnorm(ARGP(0), ARGP(3), XN, gw, NGW, lane);
        } else {
            const int ck = (p - 1) / NPH, k = (p - 1) % NPH;
            const int S = ck < 2 ? 2048 : 4096;
            const float* xin = ck < 2 ? ARGP(0) + (size_t)ck * CH * DM : ARGP(1);
            float* out = (float*)ARGP(19) + (size_t)ck * CH * DM;
            if (EN(0) && k == 0) {
                pg8::Gemm g{XN, WIN, CH, DIN, DM}; pg8::StaticOrder So; So.init(CH, DIN, G, (int)blockIdx.x);
                pg8::EpiZ E{Z};
                pg8::gemm_phase<pg8::EpiZ, pg8::StaticOrder, true, true>(lds, g, So, E);
            } else if (EN(1) && k == 1) {
#ifndef NO_LRU0
                phase_lru<0>(lds, Z, WL, LSUM, LCAR, RNN, S, tid, lane, wave, G);
                __syncthreads();
#endif
#ifndef NO_ATTN
                phase_attn(lds, Z, ARGP(2), OG, LSE, S, tid, lane, wave, G);
#endif
            } else if (EN(2) && k == 2) {
                phase_lru_carry(LSUM, LCAR, S, tid, G);
                phase_combine(OG, LSE, ATT, tid, G);
            } else if (EN(3) && k == 3) {
                phase_lru<1>(lds, Z, WL, LSUM, LCAR, RNN, S, tid, lane, wave, G);
            } else if (EN(4) && k == 4) {
                { pg8::Gemm g{ATT, WAO, CH, DM, AW}; pg8::StaticOrder So; So.init(CH, DM, G, (int)blockIdx.x);
                  pg8::EpiGate<false> E{Z + C_GA, MG};
                  pg8::gemm_phase<pg8::EpiGate<false>, pg8::StaticOrder, true, true>(lds, g, So, E); }
                { pg8::Gemm g{RNN, WRO, CH, DM, LW}; pg8::StaticOrder So; So.init(CH, DM, G, (int)blockIdx.x);
                  pg8::EpiGate<true> E{Z + C_GR, MG};
                  pg8::gemm_phase<pg8::EpiGate<true>, pg8::StaticOrder, true, true>(lds, g, So, E); }
            } else if (EN(5) && k == 5) {
                pg8::Gemm g{MG, WOUT, CH, DM, DM}; pg8::StaticOrder So; So.init(CH, DM, G, (int)blockIdx.x);
                pg8::EpiX1 E{xin, XN, SS};
                pg8::gemm_phase<pg8::EpiX1, pg8::StaticOrder, true, true>(lds, g, So, E);
            } else if (EN(6) && k == 6) {
                pg8::Gemm g{XN, W1, CH, DFF, DM}; pg8::StaticOrder So; So.init(CH, DFF, G, (int)blockIdx.x);
                pg8::EpiMlpUp E{SS, HB};
                pg8::gemm_phase<pg8::EpiMlpUp, pg8::StaticOrder, true, true>(lds, g, So, E);
            } else if (EN(7) && k == 7) {
                pg8::Gemm g{HB, W2, CH, DM, DFF}; pg8::StaticOrder So; So.init(CH, DM, G, (int)blockIdx.x);
                pg8::EpiX2 E{XN, out, SS};
                pg8::gemm_phase<pg8::EpiX2, pg8::StaticOrder, true, true>(lds, g, So, E);
            } else if (EN(8)) {
                phase_final_norm(out, SS, ARGP(18), gw, NGW, lane);
                if (ck + 1 < NCH) { const float* xn = (ck + 1) < 2 ? ARGP(0) + (size_t)(ck + 1) * CH * DM : ARGP(1); phase_xnorm(xn, ARGP(3), XN, gw, NGW, lane); }
            }
        }
        if (REP_MASK != 0 && !(q & 1)) continue;
        if (p + 1 < ph_hi) GRID_BAR();
    }
}

extern "C" void kernel_launch(void* const* d_in, const int* in_sizes, int n_in, void* d_out, int out_size, void* d_ws, size_t ws_size, hipStream_t stream) {
    static int grid = 0;
    if (grid == 0) {
        if (n_in != 19 || ws_size < WS_END) { fprintf(stderr, "kernel_launch: unexpected n_in %d / ws_size %zu\n", n_in, ws_size); grid = -1; return; }
        int dev = 0, cus = 0, per_cu = 0;
        hipGetDevice(&dev); hipDeviceGetAttribute(&cus, hipDeviceAttributeMultiprocessorCount, dev);
        if (hipFuncSetAttribute((const void*)fwd_kernel, hipFuncAttributeMaxDynamicSharedMemorySize, LDS_BYTES) != hipSuccess) { fprintf(stderr, "kernel_launch: hipFuncSetAttribute failed\n"); grid = -1; return; }
        hipOccupancyMaxActiveBlocksPerMultiprocessor(&per_cu, (const void*)fwd_kernel, 512, LDS_BYTES);
        (void)hipGetLastError();
        if (per_cu < 1) fprintf(stderr, "kernel_launch: occupancy query says %d blocks per CU\n", per_cu);
        grid = cus > 0 ? cus : 256;
    }
    if (grid < 0) return;
    if (hipMemsetAsync(d_ws, 0, 65536, stream) != hipSuccess) { fprintf(stderr, "kernel_launch: hipMemsetAsync failed\n"); return; }
    Args a{};
    for (int i = 0; i < 19; ++i) a.in[i] = (const float*)d_in[i];
    a.out = (float*)d_out; a.ws = (unsigned char*)d_ws;
#if MK_MULTI
    for (int p = 0; p < NPHASES; ++p) { a.ph_lo = p; a.ph_hi = p + 1; hipLaunchKernelGGL(fwd_kernel, dim3(grid), dim3(512), LDS_BYTES, stream, a); }
#else
    a.ph_lo = 0; a.ph_hi = NPHASES;
    void* kargs[] = {&a};
    hipError_t e = hipLaunchCooperativeKernel((const void*)fwd_kernel, dim3(grid), dim3(512), kargs, LDS_BYTES, stream);
    if (e != hipSuccess) fprintf(stderr, "kernel_launch: cooperative launch failed: %s (grid %d)\n", hipGetErrorString(e), grid);
#endif
}
```

```cpp
#include <hip/hip_runtime.h>
#include <hip/hip_cooperative_groups.h>
#include <cstdio>
#include <cstdint>
namespace cg = cooperative_groups;

#ifndef MK_MULTI
#define MK_MULTI 0
#endif

constexpr int DM = 2048, CH = 16384, NCH = 3;
constexpr int DIN = 11776;
constexpr int C_Q = 0, C_K = 1536, C_V = 3072, C_RX = 4608, C_RY = 6144, C_GA = 7680, C_GR = 9728;
constexpr int DFF = 8192, AW = 512, LW = 1536;
constexpr float NORM_EPS = 1e-6f;
constexpr float LOG2E = 1.4426950408889634f;
constexpr float QSCALE = 0.08838834764831845f * 1.4426950408889634f;

namespace pg8 {
#define PG8_LAS __attribute__((address_space(3)))
typedef unsigned short bf16_t;
typedef short bf16x8 __attribute__((ext_vector_type(8)));
typedef float f32x4 __attribute__((ext_vector_type(4)));
typedef unsigned u32x4 __attribute__((ext_vector_type(4)));
constexpr int BM = 256, BK = 64, HALF = 128, HTB = HALF * BK * 2  , STAGE_BYTES = 8 * HTB, NXCD = 8, WGM = 8;

__host__ __device__ __forceinline__ int lds_byte(int r, int c) { const int st = (r >> 4) * 2 + (c >> 5), rr = r & 15, cc = c & 31, ob = rr * 64 + cc * 2; return st * 1024 + (ob ^ (((ob >> 9) & 1) << 5)); }
__host__ __device__ __forceinline__ void stage_rc(int b, int& R, int& C) { const int st = b / 1024, sb = b % 1024, swz = sb ^ (((sb >> 9) & 1) << 5); R = (st >> 1) * 16 + swz / 64; C = (st & 1) * 32 + (swz % 64) / 2; }
__host__ __device__ __forceinline__ int perm32(int rho) { const int n = rho >> 4, i = rho & 15; return 8 * (i >> 2) + 4 * n + (i & 3); }

struct Unit { int pm, pn; };
struct Gemm { const bf16_t* A; const bf16_t* Bt; int M, N, K; };

struct StaticOrder {
    int nM, nN, nwg, G, c;
    __host__ __device__ void init(int M, int N, int G_, int c_) { nM = M / BM; nN = N / BM; nwg = nM * nN; G = G_; c = c_; }
    __host__ __device__ bool next(int i, Unit& u) const {
        const long L = (long)i * G + c; if (L >= nwg) return false;
        int wgid = (int)L; { const int q = nwg / NXCD, r = nwg % NXCD, xcd = wgid % NXCD, off = wgid / NXCD; wgid = (xcd < r ? xcd * (q + 1) : r * (q + 1) + (xcd - r) * q) + off; }
        const int nig = WGM * nN, gid = wgid / nig, fm = gid * WGM, gsz = (nM - fm) < WGM ? (nM - fm) : WGM;
        u.pm = fm + ((wgid % nig) % gsz); u.pn = (wgid % nig) / gsz; return true;
    }
    __device__ __forceinline__ void a_ready(const Unit&) const {}
    __device__ __forceinline__ void done(const Unit&) const {}
};

typedef float f32x2c_t __attribute__((ext_vector_type(2))); typedef __bf16 bf16x2c_t __attribute__((ext_vector_type(2)));
__device__ __forceinline__ unsigned cvt_pk_bf16(float lo, float hi) { const f32x2c_t v = {lo, hi}; const bf16x2c_t b = __builtin_convertvector(v, bf16x2c_t); return __builtin_bit_cast(unsigned, b); }
typedef float f32x2 __attribute__((ext_vector_type(2)));
typedef unsigned u32x2 __attribute__((ext_vector_type(2)));
__device__ __forceinline__ float sigmoidf_fast(float x) { return __builtin_amdgcn_rcpf(1.0f + __builtin_amdgcn_exp2f(-1.4426950408889634f * x)); }
__device__ __forceinline__ float bf_lo(unsigned w) { return __uint_as_float(w << 16); }
__device__ __forceinline__ float bf_hi(unsigned w) { return __uint_as_float(w & 0xffff0000u); }

struct EpiZ {
    static constexpr bool PERM = true, AFTER_DRAIN = false;
    bf16_t* Z; unsigned char* G8;
    __device__ __forceinline__ void operator()(const f32x4 (&acc)[2][2][4][2], const Unit& u, int wr, int wc, int fr, int fq) const {
        const int row0 = u.pm * BM + wr * 64 + fr, col0 = u.pn * BM + wc * 32 + 8 * fq;
        if (u.pn >= 30) {
            const int tidn = (wr * 4 + wc) * 64 + fq * 16 + fr;
            u32x4* gp = (u32x4*)G8 + (size_t)(u.pm * 16 + (u.pn - 30)) * 8 * 512 + tidn;
#pragma unroll
            for (int ai = 0; ai < 2; ++ai)
#pragma unroll
                for (int m = 0; m < 4; ++m) { unsigned q[16];
#pragma unroll
                    for (int bj = 0; bj < 2; ++bj) { const f32x4 v0 = acc[ai][bj][m][0], v1 = acc[ai][bj][m][1];
#pragma unroll
                        for (int e = 0; e < 4; ++e) { q[8 * bj + e] = (unsigned)fmaf(sigmoidf_fast(v0[e]), 255.0f, 0.5f); q[8 * bj + 4 + e] = (unsigned)fmaf(sigmoidf_fast(v1[e]), 255.0f, 0.5f); } }
                    u32x4 w; w.x = q[0] | (q[1] << 8) | (q[2] << 16) | (q[3] << 24); w.y = q[4] | (q[5] << 8) | (q[6] << 16) | (q[7] << 24);
                    w.z = q[8] | (q[9] << 8) | (q[10] << 16) | (q[11] << 24); w.w = q[12] | (q[13] << 8) | (q[14] << 16) | (q[15] << 24);
                    gp[(ai * 4 + m) * 512] = w; }
            return;
        }
        const bool qs = u.pn < 6;
#pragma unroll
        for (int ai = 0; ai < 2; ++ai)
#pragma unroll
            for (int m = 0; m < 4; ++m) { bf16_t* rowp = Z + (size_t)(row0 + ai * HALF + m * 16) * DIN + col0;
#pragma unroll
                for (int bj = 0; bj < 2; ++bj) { f32x4 v0 = acc[ai][bj][m][0], v1 = acc[ai][bj][m][1];
                    if (qs) { v0 = v0 * QSCALE; v1 = v1 * QSCALE; }
                    u32x4 w; w.x = cvt_pk_bf16(v0[0], v0[1]); w.y = cvt_pk_bf16(v0[2], v0[3]); w.z = cvt_pk_bf16(v1[0], v1[1]); w.w = cvt_pk_bf16(v1[2], v1[3]);
                    *(u32x4*)(rowp + bj * HALF) = w; } }
    }
};
template <bool SECOND> struct EpiGate {
    static constexpr bool PERM = true, AFTER_DRAIN = false;
    const unsigned char* G8; int gsel; u32x4* M1; bf16_t* MG;
    __device__ __forceinline__ void operator()(const f32x4 (&acc)[2][2][4][2], const Unit& u, int wr, int wc, int fr, int fq) const {
        const int row0 = u.pm * BM + wr * 64 + fr, col0 = u.pn * BM + wc * 32 + 8 * fq;
        const int tidn = (wr * 4 + wc) * 64 + fq * 16 + fr;
        const u32x4* gp = (const u32x4*)G8 + (size_t)(u.pm * 16 + gsel + u.pn) * 8 * 512 + tidn;
        u32x4* mp = M1 + (size_t)(u.pm * 8 + u.pn) * 16 * 512 + tidn;
        constexpr float K255 = 1.0f / 255.0f;
#pragma unroll
        for (int ai = 0; ai < 2; ++ai)
#pragma unroll
            for (int m = 0; m < 4; ++m) { const size_t row = (size_t)(row0 + ai * HALF + m * 16);
                const u32x4 gw = gp[(ai * 4 + m) * 512];
                u32x4 pw[2];
                if (SECOND) { pw[0] = mp[((ai * 4 + m) * 2 + 0) * 512]; pw[1] = mp[((ai * 4 + m) * 2 + 1) * 512]; }
#pragma unroll
                for (int bj = 0; bj < 2; ++bj) { const unsigned gx = bj ? gw.z : gw.x, gy = bj ? gw.w : gw.y;
                    const f32x4 g0 = (f32x4){(float)(gx & 255u), (float)((gx >> 8) & 255u), (float)((gx >> 16) & 255u), (float)(gx >> 24)} * K255,
                                g1 = (f32x4){(float)(gy & 255u), (float)((gy >> 8) & 255u), (float)((gy >> 16) & 255u), (float)(gy >> 24)} * K255;
                    f32x4 v0 = acc[ai][bj][m][0] * g0, v1 = acc[ai][bj][m][1] * g1;
                    if (SECOND) { const u32x4 p = pw[bj];
                        v0 = v0 + (f32x4){bf_lo(p.x), bf_hi(p.x), bf_lo(p.y), bf_hi(p.y)}; v1 = v1 + (f32x4){bf_lo(p.z), bf_hi(p.z), bf_lo(p.w), bf_hi(p.w)}; }
                    u32x4 w; w.x = cvt_pk_bf16(v0[0], v0[1]); w.y = cvt_pk_bf16(v0[2], v0[3]); w.z = cvt_pk_bf16(v1[0], v1[1]); w.w = cvt_pk_bf16(v1[2], v1[3]);
                    if (SECOND) *(u32x4*)(MG + row * DM + col0 + bj * HALF) = w; else mp[((ai * 4 + m) * 2 + bj) * 512] = w; }
                if (SECOND ? (m & 1) : (m == 3)) asm volatile("" ::: "memory"); }
    }
};
struct EpiX1 {
    static constexpr bool PERM = true, AFTER_DRAIN = false;
    const float* base; bf16_t* XN; float* SS;
    __device__ __forceinline__ void operator()(const f32x4 (&acc)[2][2][4][2], const Unit& u, int wr, int wc, int fr, int fq) const {
        const int row0 = u.pm * BM + wr * 64 + fr, col0 = u.pn * BM + wc * 32 + 8 * fq;
#pragma unroll
        for (int ai = 0; ai < 2; ++ai)
#pragma unroll
            for (int m = 0; m < 4; ++m) { const size_t row = (size_t)(row0 + ai * HALF + m * 16); float ss = 0.f;
#pragma unroll
                for (int bj = 0; bj < 2; ++bj) { const size_t off = row * DM + col0 + bj * HALF;
                    f32x4 v0 = acc[ai][bj][m][0] + *(const f32x4*)(base + off), v1 = acc[ai][bj][m][1] + *(const f32x4*)(base + off + 4);
                    u32x4 w; w.x = cvt_pk_bf16(v0[0], v0[1]); w.y = cvt_pk_bf16(v0[2], v0[3]); w.z = cvt_pk_bf16(v1[0], v1[1]); w.w = cvt_pk_bf16(v1[2], v1[3]);
                    *(u32x4*)(XN + off) = w;
                    v0 = (f32x4){bf_lo(w.x), bf_hi(w.x), bf_lo(w.y), bf_hi(w.y)}; v1 = (f32x4){bf_lo(w.z), bf_hi(w.z), bf_lo(w.w), bf_hi(w.w)};
                    ss += (v0[0] * v0[0] + v0[1] * v0[1]) + (v0[2] * v0[2] + v0[3] * v0[3]) + (v1[0] * v1[0] + v1[1] * v1[1]) + (v1[2] * v1[2] + v1[3] * v1[3]); }
                ss += __shfl_xor(ss, 16); ss += __shfl_xor(ss, 32);
                if (fq == 0) SS[row * 32 + u.pn * 4 + wc] = ss; }
    }
};
struct EpiX2 {
    static constexpr bool PERM = true, AFTER_DRAIN = false;
    const bf16_t* XN; bf16_t* X2; float* SS;
    __device__ __forceinline__ void operator()(const f32x4 (&acc)[2][2][4][2], const Unit& u, int wr, int wc, int fr, int fq) const {
        const int row0 = u.pm * BM + wr * 64 + fr, col0 = u.pn * BM + wc * 32 + 8 * fq;
#pragma unroll
        for (int ai = 0; ai < 2; ++ai)
#pragma unroll
            for (int m = 0; m < 4; ++m) { const size_t row = (size_t)(row0 + ai * HALF + m * 16); float ss = 0.f;
#pragma unroll
                for (int bj = 0; bj < 2; ++bj) { const size_t off = row * DM + col0 + bj * HALF;
                    const u32x4 pw = *(const u32x4*)(XN + off);
                    f32x4 v0 = acc[ai][bj][m][0] + (f32x4){bf_lo(pw.x), bf_hi(pw.x), bf_lo(pw.y), bf_hi(pw.y)}, v1 = acc[ai][bj][m][1] + (f32x4){bf_lo(pw.z), bf_hi(pw.z), bf_lo(pw.w), bf_hi(pw.w)};
                    u32x4 w; w.x = cvt_pk_bf16(v0[0], v0[1]); w.y = cvt_pk_bf16(v0[2], v0[3]); w.z = cvt_pk_bf16(v1[0], v1[1]); w.w = cvt_pk_bf16(v1[2], v1[3]);
                    *(u32x4*)(X2 + off) = w;
                    v0 = (f32x4){bf_lo(w.x), bf_hi(w.x), bf_lo(w.y), bf_hi(w.y)}; v1 = (f32x4){bf_lo(w.z), bf_hi(w.z), bf_lo(w.w), bf_hi(w.w)};
                    ss += (v0[0] * v0[0] + v0[1] * v0[1]) + (v0[2] * v0[2] + v0[3] * v0[3]) + (v1[0] * v1[0] + v1[1] * v1[1]) + (v1[2] * v1[2] + v1[3] * v1[3]); }
                ss += __shfl_xor(ss, 16); ss += __shfl_xor(ss, 32);
                if (fq == 0) SS[row * 32 + u.pn * 4 + wc] = ss; }
    }
};
struct EpiMlpUp {
    static constexpr bool PERM = true, AFTER_DRAIN = false;
    const float* RS; bf16_t* H;
    __device__ __forceinline__ void operator()(const f32x4 (&acc)[2][2][4][2], const Unit& u, int wr, int wc, int fr, int fq) const {
        const int row0 = u.pm * BM + wr * 64 + fr, col0 = u.pn * BM + wc * 32 + 8 * fq;
        float rs[2][4];
#pragma unroll
        for (int ai = 0; ai < 2; ++ai)
#pragma unroll
            for (int m = 0; m < 4; ++m) rs[ai][m] = RS[row0 + ai * HALF + m * 16];
#pragma unroll
        for (int ai = 0; ai < 2; ++ai)
#pragma unroll
            for (int m = 0; m < 4; ++m) { const size_t row = (size_t)(row0 + ai * HALF + m * 16); const float rstd = rs[ai][m];
#pragma unroll
                for (int bj = 0; bj < 2; ++bj) { f32x4 v0 = acc[ai][bj][m][0] * rstd, v1 = acc[ai][bj][m][1] * rstd;
#pragma unroll
                    for (int e = 0; e < 4; ++e) { const float a = fmaxf(v0[e], 0.f), b = fmaxf(v1[e], 0.f); v0[e] = a * a; v1[e] = b * b; }
                    u32x4 w; w.x = cvt_pk_bf16(v0[0], v0[1]); w.y = cvt_pk_bf16(v0[2], v0[3]); w.z = cvt_pk_bf16(v1[0], v1[1]); w.w = cvt_pk_bf16(v1[2], v1[3]);
                    *(u32x4*)(H + row * DFF + col0 + bj * HALF) = w; } }
    }
};

template <class Epi, class Sched, bool ALIGN_EPI = false, bool SP2 = false>
__device__ __forceinline__ void gemm_phase(PG8_LAS unsigned char* lds, const Gemm g, const Sched& S, const Epi& E) {
    int tid_ = threadIdx.x; asm volatile("" : "+v"(tid_));
    const int tid = tid_, wid = __builtin_amdgcn_readfirstlane(tid >> 6), lane = tid & 63, wr = wid >> 2, wc = wid & 3, fr = lane & 15, fq = lane >> 4;
    const int K = g.K, nt = K / BK;
    unsigned voffA[2], voffB[2];
#pragma unroll
    for (int i = 0; i < 2; ++i) { int R, C; stage_rc(tid * 16 + i * 8192, R, C); const int Rb = Epi::PERM ? ((R & ~31) + perm32(R & 31)) : R;
        voffA[i] = (unsigned)(R * K + C) * 2u; voffB[i] = (unsigned)(Rb * K + C) * 2u; }
    const size_t kstep = (size_t)(BK * 2);
    const size_t hstep = (size_t)HALF * K * 2;
    const size_t tstep = 2 * hstep;
    const unsigned ldsw = (unsigned)wid * 1024u;
    const int aoff = lds_byte(wr * 64 + fr, fq * 8), boff = lds_byte(wc * 32 + fr, fq * 8);
#define PG8_SA(b, h) (((b) * 2 + (h)) * HTB)
#define PG8_SB(b, h) ((4 + (b) * 2 + (h)) * HTB)
#define PG8_STAGE(bufoff, gbase, voff) do { _Pragma("unroll") for (int _i = 0; _i < 2; ++_i) \
        __builtin_amdgcn_global_load_lds((const unsigned*)((const char*)(gbase) + (voff)[_i]), (PG8_LAS unsigned*)(lds + (bufoff) + ldsw + _i * 8192), 16, 0, 0); } while (0)
#define PG8_LDA(dst, b, h) do { _Pragma("unroll") for (int m = 0; m < 4; ++m) _Pragma("unroll") for (int k = 0; k < 2; ++k) dst[m][k] = *(const PG8_LAS bf16x8*)(lds + PG8_SA(b, h) + aoff + m * 2048 + k * 1024); } while (0)
#define PG8_LDB(dst, b, h) do { _Pragma("unroll") for (int n = 0; n < 2; ++n) _Pragma("unroll") for (int k = 0; k < 2; ++k) dst[n][k] = *(const PG8_LAS bf16x8*)(lds + PG8_SB(b, h) + boff + n * 2048 + k * 1024); } while (0)
#define PG8_MMA(ai, bj, At, Bt) do { __builtin_amdgcn_s_setprio(1); _Pragma("unroll") for (int m = 0; m < 4; ++m) _Pragma("unroll") for (int n = 0; n < 2; ++n) _Pragma("unroll") for (int k = 0; k < 2; ++k) \
        acc[ai][bj][m][n] = __builtin_amdgcn_mfma_f32_16x16x32_bf16(Bt[n][k], At[m][k], acc[ai][bj][m][n], 0, 0, 0); __builtin_amdgcn_s_setprio(0); } while (0)
#define PG8_WAIT_V(n) asm volatile("s_waitcnt vmcnt(" #n ")" ::: "memory")
#define PG8_WAIT_L(n) asm volatile("s_waitcnt lgkmcnt(" #n ")" ::: "memory")
#define PG8_BAR __builtin_amdgcn_s_barrier()
#define PG8_SCHED __builtin_amdgcn_sched_barrier(0)
    Unit cur, nxt; int ui = 0;
    if (!S.next(0, cur)) return;
    f32x4 acc[2][2][4][2];
#pragma unroll
    for (int a = 0; a < 2; ++a)
#pragma unroll
        for (int b = 0; b < 2; ++b)
#pragma unroll
            for (int m = 0; m < 4; ++m)
#pragma unroll
                for (int n = 0; n < 2; ++n) acc[a][b][m][n] = (f32x4){0.f, 0.f, 0.f, 0.f};
    bf16x8 At[4][2], B0[2][2], B1[2][2];
    const char* cA = (const char*)g.A + (size_t)cur.pm * tstep; const char* cB = (const char*)g.Bt + (size_t)cur.pn * tstep;
    S.a_ready(cur);
    if constexpr (SP2) {
        PG8_STAGE(PG8_SB(0, 0), cB, voffB); PG8_STAGE(PG8_SB(0, 1), cB + hstep, voffB); PG8_STAGE(PG8_SA(0, 0), cA, voffA); PG8_STAGE(PG8_SA(0, 1), cA + hstep, voffA);
        if (wr == 1) PG8_BAR;
        PG8_WAIT_V(2); PG8_BAR;
        PG8_STAGE(PG8_SB(1, 0), cB + kstep, voffB); PG8_STAGE(PG8_SA(1, 0), cA + kstep, voffA); PG8_STAGE(PG8_SB(1, 1), cB + hstep + kstep, voffB);
        PG8_WAIT_V(6); PG8_BAR;
    } else {
        PG8_STAGE(PG8_SB(0, 0), cB, voffB); PG8_STAGE(PG8_SA(0, 0), cA, voffA); PG8_STAGE(PG8_SB(0, 1), cB + hstep, voffB); PG8_STAGE(PG8_SA(0, 1), cA + hstep, voffA);
        if (wr == 1) PG8_BAR;
        PG8_WAIT_V(4); PG8_BAR;
        PG8_STAGE(PG8_SB(1, 0), cB + kstep, voffB); PG8_STAGE(PG8_SA(1, 0), cA + kstep, voffA); PG8_STAGE(PG8_SB(1, 1), cB + hstep + kstep, voffB);
        PG8_WAIT_V(6); PG8_BAR;
    }
    for (;;) {
        const bool has_next = S.next(ui + 1, nxt);
        const char* nA = has_next ? (const char*)g.A + (size_t)nxt.pm * tstep : cA; const char* nB = has_next ? (const char*)g.Bt + (size_t)nxt.pn * tstep : cB;
        for (int t = 0; t < nt; t += 2) {
            const bool last = (t == nt - 2);
            const char* a1 = cA + (size_t)(t + 1) * kstep;
            const char* a2 = last ? nA : cA + (size_t)(t + 2) * kstep; const char* b2 = last ? nB : cB + (size_t)(t + 2) * kstep;
            const char* a3 = a2 + kstep; const char* b3 = b2 + kstep;
            if (last && has_next) S.a_ready(nxt);
            if constexpr (SP2) {
            PG8_LDB(B0, 0, 0); PG8_LDB(B1, 0, 1); PG8_SCHED; PG8_LDA(At, 0, 0); PG8_STAGE(PG8_SA(1, 1), a1 + hstep, voffA);
            PG8_WAIT_V(8); PG8_WAIT_L(0); PG8_BAR; PG8_MMA(0, 0, At, B0); PG8_MMA(0, 1, At, B1); PG8_BAR; PG8_SCHED;
            PG8_LDA(At, 0, 1); PG8_STAGE(PG8_SB(0, 0), b2, voffB); PG8_STAGE(PG8_SB(0, 1), b2 + hstep, voffB); PG8_STAGE(PG8_SA(0, 0), a2, voffA);
            PG8_WAIT_V(8); PG8_WAIT_L(0); PG8_BAR; PG8_MMA(1, 0, At, B0); PG8_MMA(1, 1, At, B1); PG8_BAR; PG8_SCHED;
            PG8_LDB(B0, 1, 0); PG8_LDB(B1, 1, 1); PG8_SCHED; PG8_LDA(At, 1, 0); PG8_STAGE(PG8_SA(0, 1), a2 + hstep, voffA);
            PG8_WAIT_V(8); PG8_WAIT_L(0); PG8_BAR; PG8_MMA(0, 0, At, B0); PG8_MMA(0, 1, At, B1); PG8_BAR; PG8_SCHED;
            PG8_LDA(At, 1, 1); PG8_STAGE(PG8_SB(1, 0), b3, voffB); PG8_STAGE(PG8_SB(1, 1), b3 + hstep, voffB); PG8_STAGE(PG8_SA(1, 0), a3, voffA);
            PG8_WAIT_V(8); PG8_WAIT_L(0); PG8_BAR; PG8_MMA(1, 0, At, B0); PG8_MMA(1, 1, At, B1); PG8_BAR; PG8_SCHED;
            } else {
            PG8_LDB(B0, 0, 0); PG8_SCHED; PG8_LDA(At, 0, 0); PG8_STAGE(PG8_SA(1, 1), a1 + hstep, voffA);
            PG8_WAIT_L(8); PG8_BAR; PG8_WAIT_L(0); PG8_MMA(0, 0, At, B0); PG8_BAR; PG8_SCHED;
            PG8_LDB(B1, 0, 1); PG8_STAGE(PG8_SB(0, 0), b2, voffB);
            PG8_BAR; PG8_WAIT_L(0); PG8_MMA(0, 1, At, B1); PG8_BAR;
            PG8_LDA(At, 0, 1); PG8_STAGE(PG8_SA(0, 0), a2, voffA);
            PG8_BAR; PG8_WAIT_L(0); PG8_MMA(1, 0, At, B0); PG8_BAR; PG8_SCHED;
            PG8_STAGE(PG8_SB(0, 1), b2 + hstep, voffB);
            PG8_WAIT_V(6); PG8_BAR; PG8_MMA(1, 1, At, B1); PG8_BAR;
            PG8_LDB(B0, 1, 0); PG8_SCHED; PG8_LDA(At, 1, 0); PG8_STAGE(PG8_SA(0, 1), a2 + hstep, voffA);
            PG8_WAIT_L(8); PG8_BAR; PG8_WAIT_L(0); PG8_MMA(0, 0, At, B0); PG8_BAR; PG8_SCHED;
            PG8_LDB(B1, 1, 1); PG8_STAGE(PG8_SB(1, 0), b3, voffB);
            PG8_BAR; PG8_WAIT_L(0); PG8_MMA(0, 1, At, B1); PG8_BAR;
            PG8_LDA(At, 1, 1); PG8_STAGE(PG8_SA(1, 0), a3, voffA);
            PG8_BAR; PG8_WAIT_L(0); PG8_MMA(1, 0, At, B0); PG8_BAR; PG8_SCHED;
            PG8_STAGE(PG8_SB(1, 1), b3 + hstep, voffB);
            PG8_WAIT_V(6); PG8_BAR; PG8_MMA(1, 1, At, B1); PG8_BAR;
            }
        }
        if constexpr (ALIGN_EPI) { if (wr == 0) PG8_BAR; }
        if constexpr (!Epi::AFTER_DRAIN) { E(acc, cur, wr, wc, fr, fq); S.done(cur); }
        if (!has_next) break;
#pragma unroll
        for (int a = 0; a < 2; ++a)
#pragma unroll
            for (int b = 0; b < 2; ++b)
#pragma unroll
                for (int m = 0; m < 4; ++m)
#pragma unroll
                    for (int n = 0; n < 2; ++n) acc[a][b][m][n] = (f32x4){0.f, 0.f, 0.f, 0.f};
        cur = nxt; cA = nA; cB = nB; ++ui;
        if constexpr (ALIGN_EPI) { if (wr == 1) PG8_BAR; }
    }
    PG8_WAIT_V(0);
    if constexpr (!ALIGN_EPI) { if (wr == 0) PG8_BAR; }
    PG8_BAR;
    if constexpr (Epi::AFTER_DRAIN) { E.fused(acc, cur, wr, wc, fr, fq, lds, wid, lane); S.done(cur); }
#undef PG8_SA
#undef PG8_SB
#undef PG8_STAGE
#undef PG8_LDA
#undef PG8_LDB
#undef PG8_MMA
#undef PG8_WAIT_V
#undef PG8_WAIT_L
#undef PG8_BAR
#undef PG8_SCHED
}
}

constexpr size_t MiB = (size_t)1 << 20;
constexpr size_t WS_CTL = 0;
constexpr size_t WS_WIN = 1 * MiB;
constexpr size_t WS_WAO = 47 * MiB;
constexpr size_t WS_WRO = 49 * MiB;
constexpr size_t WS_WOUT = 55 * MiB;
constexpr size_t WS_W1 = 63 * MiB;
constexpr size_t WS_W2 = 95 * MiB;
constexpr size_t WS_WL = 127 * MiB;
constexpr size_t WS_SS = 129 * MiB;
constexpr size_t WS_LSUM = 131 * MiB;
constexpr size_t WS_LCAR = 137 * MiB;
constexpr size_t WS_LSE = 140 * MiB;
constexpr size_t WS_XN = 141 * MiB;
constexpr size_t WS_ATT = 205 * MiB;
constexpr size_t WS_RNN = 221 * MiB;
constexpr size_t WS_OG = 269 * MiB;
constexpr size_t WS_MG = 317 * MiB;
constexpr size_t WS_G8 = 445 * MiB;
constexpr size_t WS_X2B = 381 * MiB;
constexpr size_t WS_Z = 509 * MiB;
constexpr size_t WS_END = 877 * MiB;

constexpr int LDS_BYTES = 131072 + 16384;
constexpr int NPH = 10;
constexpr int NPHASES = 1 + NCH * NPH;

#define LAS __attribute__((address_space(3)))
typedef unsigned short bf16_t;
typedef short bf16x8 __attribute__((ext_vector_type(8)));
typedef short s16x4 __attribute__((ext_vector_type(4)));
typedef float f32x4 __attribute__((ext_vector_type(4)));
typedef unsigned u32x4 __attribute__((ext_vector_type(4)));
typedef unsigned u32x2 __attribute__((ext_vector_type(2)));
#define LDS_WAIT() asm volatile("s_waitcnt lgkmcnt(0)" ::: "memory")

__device__ __forceinline__ unsigned pk2(float lo, float hi) { return pg8::cvt_pk_bf16(lo, hi); }
__device__ __forceinline__ float bflo(unsigned w) { return __uint_as_float(w << 16); }
__device__ __forceinline__ float bfhi(unsigned w) { return __uint_as_float(w & 0xffff0000u); }
__device__ __forceinline__ float wave_sum(float v) {
#pragma unroll
    for (int o = 1; o < 64; o <<= 1) v += __shfl_xor(v, o);
    return v;
}
__device__ __forceinline__ float fast_sigmoid(float x) { return __builtin_amdgcn_rcpf(1.0f + __builtin_amdgcn_exp2f(-LOG2E * x)); }
__device__ __forceinline__ unsigned off_b(unsigned row, unsigned ch) { return 256u * row + 16u * (ch ^ (((row & 3u) << 2) | ((row >> 2) & 3u))); }
__device__ __forceinline__ s16x4 ldtr(LAS const unsigned char* p) { return __builtin_bit_cast(s16x4, __builtin_amdgcn_ds_read_tr16_b64_v4i16((LAS s16x4*)p)); }
template <int CTRL> __device__ __forceinline__ float dpp_f(float old, float v) {
    return __int_as_float(__builtin_amdgcn_update_dpp(__float_as_int(old), __float_as_int(v), CTRL, 0xf, 0xf, false));
}

struct Args { const float* in[19]; float* out; unsigned char* ws; int ph_lo, ph_hi; };
__device__ __forceinline__ unsigned long long ldsptr(LAS unsigned char* lds, int i) {
    const LAS unsigned* p = (const LAS unsigned*)(lds + 131072 + 8 * i);
    const unsigned lo = __builtin_amdgcn_readfirstlane(p[0]), hi = __builtin_amdgcn_readfirstlane(p[1]);
    return ((unsigned long long)hi << 32) | lo;
}
#define GAS __attribute__((address_space(1)))
#define ARGP(i) ((const float*)(GAS const float*)ldsptr(lds, (i)))

#define XB_TMO      128
#define XB_XCNT(j)  (256  + 64 * (j))
#define XB_XSUB(j)  (1280 + 64 * (j))
#define XB_XGEN(j)  (2304 + 64 * (j))
#define XB_TOP      3328
#define XB_TOPGEN   3392
#define XCD_BAR_WORDS 3456
#define XB_SPIN_CAP (1u << 18)

__device__ __forceinline__ unsigned xb_ld(unsigned* p)              { return __hip_atomic_load(p, __ATOMIC_RELAXED, __HIP_MEMORY_SCOPE_AGENT); }
__device__ __forceinline__ unsigned xb_add(unsigned* p, unsigned v) { return __hip_atomic_fetch_add(p, v, __ATOMIC_RELAXED, __HIP_MEMORY_SCOPE_AGENT); }
__device__ __forceinline__ unsigned xb_xcc_id() { return (unsigned)__builtin_amdgcn_s_getreg((3 << 11) | 20) & 0xFu; }
#define XB_SPIN(cond, bar) do { unsigned _sp = 0; while (cond) { __builtin_amdgcn_s_sleep(1); \
    if ((++_sp & 255u) == 0u) { if (xb_ld(&(bar)[XB_TMO])) break; if (_sp > XB_SPIN_CAP) { atomicAdd(&(bar)[XB_TMO], 1u); break; } } } } while (0)

struct XcdBarrier {
    unsigned* bar; unsigned x;
    volatile LAS unsigned* st;
};

__device__ __forceinline__ XcdBarrier xcd_barrier_post(unsigned* bar, volatile LAS unsigned* st) {
    XcdBarrier b; b.bar = bar; b.x = xb_xcc_id(); b.st = st;
    if (threadIdx.x == 0) (void)xb_add(&bar[XB_XCNT(b.x)], 1u);
    return b;
}
__device__ __forceinline__ void xcd_barrier_complete(unsigned* bar, unsigned x, unsigned& nloc, unsigned& nx) {
    const unsigned G = gridDim.x * gridDim.y * gridDim.z;
    unsigned sum, cnt, mine, sp = 0u;
    for (;;) {
        sum = 0u; cnt = 0u; mine = 0u;
#pragma unroll
        for (unsigned j = 0; j < 16; ++j) { const unsigned c = xb_ld(&bar[XB_XCNT(j)]); sum += c; cnt += (c > 0u) ? 1u : 0u; mine = (j == x) ? c : mine; }
        if (sum == G) break;
        __builtin_amdgcn_s_sleep(1);
        if ((++sp & 255u) == 0u) { if (xb_ld(&bar[XB_TMO])) break; if (sp > XB_SPIN_CAP) { atomicAdd(&bar[XB_TMO], 1u); break; } }
    }
    nloc = mine > 0u ? mine : 1u; nx = cnt > 0u ? cnt : 1u;
}

__device__ __forceinline__ void xcd_barrier(const XcdBarrier& b) {
    asm volatile("s_waitcnt vmcnt(0)" ::: "memory");
    __syncthreads();
    if (threadIdx.x == 0) {
        unsigned* bar = b.bar;
        __builtin_amdgcn_s_waitcnt(0);
        unsigned nloc = b.st[0], nx = b.st[1];
        if (nloc == 0u) { xcd_barrier_complete(bar, b.x, nloc, nx); b.st[0] = nloc; b.st[1] = nx; }
        const unsigned old = xb_add(&bar[XB_XSUB(b.x)], 1u);
        const unsigned gen = old / nloc;
        if (old + 1u == (gen + 1u) * nloc) {
            __builtin_amdgcn_fence(__ATOMIC_RELEASE, "agent");
            asm volatile("s_waitcnt vmcnt(0)" ::: "memory");
            const unsigned og = xb_add(&bar[XB_TOP], 1u);
            const unsigned tg = og / nx;
            if (og + 1u == (tg + 1u) * nx) xb_add(&bar[XB_TOPGEN], 1u);
            else XB_SPIN(xb_ld(&bar[XB_TOPGEN]) == tg, bar);
            __builtin_amdgcn_fence(__ATOMIC_ACQUIRE, "agent");
            xb_add(&bar[XB_XGEN(b.x)], 1u);
            asm volatile("s_waitcnt vmcnt(0)" ::: "memory");
        } else {
            XB_SPIN(xb_ld(&bar[XB_XGEN(b.x)]) == gen, bar);
            __builtin_amdgcn_fence(__ATOMIC_ACQUIRE, "agent");
            asm volatile("s_waitcnt vmcnt(0)" ::: "memory");
        }
    }
    __syncthreads();
}

__device__ __forceinline__ void transpose_item(const float* W, int K, int N, bf16_t* WT, const float* ksc, LAS float* scr, int item, int lane) {
    const int nblk = N / 32, kb = item / nblk, nb = item % nblk, k0 = 64 * kb, n0 = 32 * nb;
#pragma unroll
    for (int i = 0; i < 8; ++i) { const int kk = 8 * i + (lane >> 3), c4 = 4 * (lane & 7);
        f32x4 v = *(const f32x4*)(W + (size_t)(k0 + kk) * N + n0 + c4); if (ksc) v = v * ksc[k0 + kk];
        LAS float* d = scr + kk * 33 + c4; d[0] = v[0]; d[1] = v[1]; d[2] = v[2]; d[3] = v[3]; }
    LDS_WAIT(); asm volatile("" ::: "memory");
    const int c = lane & 7;
#pragma unroll
    for (int j = 0; j < 4; ++j) { const int n = (lane >> 3) + 8 * j; const LAS float* s = scr + (8 * c) * 33 + n;
        u32x4 o; o.x = pk2(s[0 * 33], s[1 * 33]); o.y = pk2(s[2 * 33], s[3 * 33]); o.z = pk2(s[4 * 33], s[5 * 33]); o.w = pk2(s[6 * 33], s[7 * 33]);
        *(u32x4*)(WT + (size_t)(n0 + n) * K + k0 + 8 * c) = o; }
    LDS_WAIT(); asm volatile("" ::: "memory");
}
__device__ __forceinline__ void phase_weights(LAS unsigned char* lds, unsigned char* ws, int part, int gw, int NGW, int wave, int lane) {
    LAS float* scr = (LAS float*)(lds + wave * 16384);
    constexpr int I_IN = (DM / 64) * (DIN / 32), I_AO = (AW / 64) * (DM / 32), I_RO = (LW / 64) * (DM / 32), I_OUT = (DM / 64) * (DM / 32),
                  I_1 = (DM / 64) * (DFF / 32), I_2 = (DFF / 64) * (DM / 32), I_L = 48 * 8;
    constexpr int NITEMS = I_IN + I_AO + I_RO + I_OUT + I_1 + I_2 + I_L;
    constexpr int NPART0 = I_IN + I_L, NPART1 = NITEMS - NPART0;
    for (int jt = gw; jt < (part == 0 ? NPART0 : NPART1); jt += NGW) {
        const int it = part == 0 ? (jt < I_IN ? jt : jt - I_IN + (NITEMS - I_L)) : jt + I_IN;
        int r = it;
        if (r < I_IN) { transpose_item(ARGP(4), DM, DIN, (bf16_t*)(ws + WS_WIN), nullptr, scr, r, lane); continue; } r -= I_IN;
        if (r < I_AO) { transpose_item(ARGP(12), AW, DM, (bf16_t*)(ws + WS_WAO), nullptr, scr, r, lane); continue; } r -= I_AO;
        if (r < I_RO) { transpose_item(ARGP(13), LW, DM, (bf16_t*)(ws + WS_WRO), nullptr, scr, r, lane); continue; } r -= I_RO;
        if (r < I_OUT) { transpose_item(ARGP(14), DM, DM, (bf16_t*)(ws + WS_WOUT), nullptr, scr, r, lane); continue; } r -= I_OUT;
        if (r < I_1) { transpose_item(ARGP(16), DM, DFF, (bf16_t*)(ws + WS_W1), ARGP(15), scr, r, lane); continue; } r -= I_1;
        if (r < I_2) { transpose_item(ARGP(17), DFF, DM, (bf16_t*)(ws + WS_W2), nullptr, scr, r, lane); continue; } r -= I_2;
        {
            const int mi = r >> 3, sub = r & 7, q = mi / 12, n = mi % 12, dir = q >> 1, type = q & 1;
            const float* src = (type ? ARGP(9) : ARGP(7)) + (size_t)(dir * 12 + n) * 128 * 128;
            transpose_item(src, 128, 128, (bf16_t*)(ws + WS_WL) + (size_t)(n * 4 + q) * 128 * 128, nullptr, scr, sub, lane);
        }
    }
}
__device__ __forceinline__ void phase_xnorm(const float* x, const float* gain, bf16_t* XN, int gw, int NGW, int lane) {
    for (int m = gw; m < CH; m += NGW) {
        const f32x4* xr = (const f32x4*)(x + (size_t)m * DM) + lane;
        f32x4 v[8]; float s = 0.f;
#pragma unroll
        for (int j = 0; j < 8; ++j) { v[j] = xr[64 * j]; s += (v[j][0] * v[j][0] + v[j][1] * v[j][1]) + (v[j][2] * v[j][2] + v[j][3] * v[j][3]); }
        const float rstd = 1.0f / sqrtf(wave_sum(s) * (1.0f / DM) + NORM_EPS);
        u32x2* o = (u32x2*)(XN + (size_t)m * DM) + lane;
#pragma unroll
        for (int j = 0; j < 8; ++j) { const f32x4 g = ((const f32x4*)gain)[64 * j + lane]; const f32x4 y = v[j] * rstd * g;
            u32x2 w; w.x = pk2(y[0], y[1]); w.y = pk2(y[2], y[3]); o[64 * j] = w; }
    }
}
__device__ __forceinline__ void phase_final_norm(float* out, const bf16_t* X2, const float* SS, const float* gain, int gw, int NGW, int lane) {
    for (int m = gw; m < CH; m += NGW) {
        const float p = lane < 32 ? SS[(size_t)m * 32 + lane] : 0.f;
        const u32x2* xr = (const u32x2*)(X2 + (size_t)m * DM) + lane;
        u32x2 xv[8];
#pragma unroll
        for (int j = 0; j < 8; ++j) xv[j] = xr[64 * j];
        const float rstd = 1.0f / sqrtf(wave_sum(p) * (1.0f / DM) + NORM_EPS);
        f32x4* o = (f32x4*)(out + (size_t)m * DM) + lane;
#pragma unroll
        for (int j = 0; j < 8; ++j) { const f32x4 g = ((const f32x4*)gain)[64 * j + lane];
            o[64 * j] = (f32x4){bflo(xv[j].x), bfhi(xv[j].x), bflo(xv[j].y), bfhi(xv[j].y)} * rstd * g; }
    }
}

constexpr int ATT_TAB = 131072 + 2048;
__device__ __forceinline__ void phase_attn(LAS unsigned char* lds, const bf16_t* Z, const float* rel_bias, bf16_t* OG, float* LSE, int S, int tid, int lane, int wave, int G) {
    LAS float* tab = (LAS float*)(lds + ATT_TAB);
    for (int e = tid; e < 12 * 192; e += 512) {
        const int hh = e / 192, ri = e % 192, rel = ri - 95, gg = hh >> 2, dist = rel * (1 << (2 * gg));
        const int n = dist < 0 ? -dist : dist; const float nf = (float)(n < 1 ? 1 : n);
        int large = 8 + (int)(logf(nf / 8.0f) / logf(128.0f) * 8.0f); large = large < 15 ? large : 15;
        const int bucket = (dist > 0 ? 16 : 0) + (n < 8 ? n : large);
        tab[e] = (rel >= -64 && rel <= 64) ? rel_bias[bucket * 12 + hh] * LOG2E : -1e30f;
    }
    __syncthreads();
    const int c = lane & 15, g4 = lane >> 4, tq = c >> 2, tp = c & 3;
    constexpr int PER_GRP = CH * 4 / 128;
    for (int item = blockIdx.x; item < 3 * PER_GRP; item += G) {
        const int grp = item / PER_GRP; int idx = item % PER_GRP;
        const int sh = 2 * grp, L = S >> sh, nblk = L >> 7;
        const int blk = idx % nblk; idx /= nblk; const int h = idx & 3; idx >>= 2; const int r = idx & ((1 << sh) - 1); const int b = idx >> sh;
        const int head = grp * 4 + h, i0 = blk * 128;
        const size_t rowbase = (size_t)b * S + r;
        const bf16_t* Zq = Z + C_Q + head * 128; const bf16_t* Zk = Z + C_K + head * 128; const bf16_t* Zv = Z + C_V + head * 128;
#pragma unroll
        for (int q = 0; q < 8; ++q) {
            const int br = 32 * wave + 4 * q + (lane >> 4); int fi = i0 - 64 + br; fi = fi < 0 ? 0 : (fi > L - 1 ? L - 1 : fi);
            const int ch = (lane & 15) ^ (((br & 3) << 2) | ((br >> 2) & 3));
            const size_t go = (rowbase + ((size_t)fi << sh)) * DIN + 8 * ch;
            __builtin_amdgcn_global_load_lds((const unsigned*)(Zk + go), (LAS unsigned*)(lds + (32 * wave + 4 * q) * 256), 16, 0, 0);
            __builtin_amdgcn_global_load_lds((const unsigned*)(Zv + go), (LAS unsigned*)(lds + 65536 + (32 * wave + 4 * q) * 256), 16, 0, 0);
        }
        const int q0 = i0 + 16 * wave;
        bf16x8 qf[4];
#pragma unroll
        for (int s = 0; s < 4; ++s) qf[s] = *(const bf16x8*)(Zq + (rowbase + ((size_t)(q0 + c) << sh)) * DIN + 32 * s + 8 * g4);
        __syncthreads();
        const int w16 = 16 * wave;
        f32x4 sa[9];
#pragma unroll
        for (int kt = 0; kt < 9; ++kt) { f32x4 acc = (f32x4){0.f, 0.f, 0.f, 0.f};
#pragma unroll
            for (int s = 0; s < 4; ++s) { const bf16x8 kf = *(const LAS bf16x8*)(lds + off_b(w16 + 16 * kt + c, 4 * s + g4));
                acc = __builtin_amdgcn_mfma_f32_16x16x32_bf16(kf, qf[s], acc, 0, 0, 0); }
            sa[kt] = acc; }
        const LAS float* tb = tab + head * 192 + 95 - 64 - c;
        const bool edge = (q0 < 64) || (q0 + 80 > L);
#pragma unroll
        for (int kt = 0; kt < 9; ++kt) { const f32x4 bv = *(const LAS f32x4*)(tb + 16 * kt + 4 * g4); sa[kt] = sa[kt] + bv; }
        if (edge) {
#pragma unroll
            for (int kt = 0; kt < 9; ++kt)
#pragma unroll
                for (int j = 0; j < 4; ++j) { const int fi = q0 - 64 + 16 * kt + 4 * g4 + j; if (fi < 0 || fi >= L) sa[kt][j] = -1e30f; }
        }
        float m = -1e30f;
#pragma unroll
        for (int kt = 0; kt < 9; ++kt) m = fmaxf(fmaxf(m, fmaxf(sa[kt][0], sa[kt][1])), fmaxf(sa[kt][2], sa[kt][3]));
        m = fmaxf(m, __shfl_xor(m, 16)); m = fmaxf(m, __shfl_xor(m, 32));
        float sum = 0.f;
#pragma unroll
        for (int kt = 0; kt < 9; ++kt)
#pragma unroll
            for (int j = 0; j < 4; ++j) { const float p = __builtin_amdgcn_exp2f(sa[kt][j] - m); sa[kt][j] = p; sum += p; }
        sum += __shfl_xor(sum, 16); sum += __shfl_xor(sum, 32);
        bf16x8 pf[5];
#pragma unroll
        for (int ks = 0; ks < 5; ++ks) { const f32x4 p0 = sa[2 * ks]; const f32x4 p1 = ks < 4 ? sa[ks < 4 ? 2 * ks + 1 : 8] : (f32x4){0.f, 0.f, 0.f, 0.f};
            u32x4 w; w.x = pk2(p0[0], p0[1]); w.y = pk2(p0[2], p0[3]); w.z = pk2(p1[0], p1[1]); w.w = pk2(p1[2], p1[3]);
            pf[ks] = __builtin_bit_cast(bf16x8, w); }
        f32x4 oa[8];
#pragma unroll
        for (int cc = 0; cc < 8; ++cc) oa[cc] = (f32x4){0.f, 0.f, 0.f, 0.f};
        LAS const unsigned char* vimg = lds + 65536;
#pragma unroll
        for (int ks = 0; ks < 5; ++ks) {
            const int r0 = w16 + 32 * ks + 4 * g4 + tq; int r1 = r0 + 16; r1 = r1 > 255 ? 255 : r1;
#pragma unroll
            for (int cc = 0; cc < 8; ++cc) {
                const s16x4 lo = ldtr(vimg + off_b(r0, 2 * cc + (tp >> 1)) + 8 * (tp & 1));
                const s16x4 hi = ldtr(vimg + off_b(r1, 2 * cc + (tp >> 1)) + 8 * (tp & 1));
                const bf16x8 vf = (bf16x8){lo[0], lo[1], lo[2], lo[3], hi[0], hi[1], hi[2], hi[3]};
                oa[cc] = __builtin_amdgcn_mfma_f32_16x16x32_bf16(vf, pf[ks], oa[cc], 0, 0, 0);
            }
        }
        {
            const float inv = 1.0f / sum;
            const size_t row = rowbase + ((size_t)(q0 + c) << sh);
            bf16_t* op = OG + ((size_t)grp * CH + row) * AW + h * 128 + 4 * g4;
#pragma unroll
            for (int cc = 0; cc < 8; ++cc) { const f32x4 o = oa[cc] * inv; u32x2 w; w.x = pk2(o[0], o[1]); w.y = pk2(o[2], o[3]); *(u32x2*)(op + 16 * cc) = w; }
            if (g4 == 0) LSE[((size_t)grp * CH + row) * 4 + h] = m + log2f(sum);
        }
        __syncthreads();
    }
}
__device__ __forceinline__ void phase_combine(const bf16_t* OG, const float* LSE, bf16_t* ATT, int tid, int G) {
    for (size_t idx = (size_t)blockIdx.x * 512 + tid; idx < (size_t)CH * 64; idx += (size_t)G * 512) {
        const size_t row = idx >> 6; const int ck = (int)(idx & 63), h = ck >> 4;
        const float l0 = LSE[(row) * 4 + h], l1 = LSE[((size_t)CH + row) * 4 + h], l2 = LSE[((size_t)2 * CH + row) * 4 + h];
        const float M = fmaxf(l0, fmaxf(l1, l2));
        float w0 = __builtin_amdgcn_exp2f(l0 - M), w1 = __builtin_amdgcn_exp2f(l1 - M), w2 = __builtin_amdgcn_exp2f(l2 - M);
        const float inv = 1.0f / (w0 + w1 + w2); w0 *= inv; w1 *= inv; w2 *= inv;
        const u32x4 a = *(const u32x4*)(OG + row * AW + ck * 8), b = *(const u32x4*)(OG + ((size_t)CH + row) * AW + ck * 8), d = *(const u32x4*)(OG + ((size_t)2 * CH + row) * AW + ck * 8);
        u32x4 o;
#pragma unroll
        for (int e = 0; e < 4; ++e) { const float lo = w0 * bflo(a[e]) + w1 * bflo(b[e]) + w2 * bflo(d[e]), hi = w0 * bfhi(a[e]) + w1 * bfhi(b[e]) + w2 * bfhi(d[e]); o[e] = pk2(lo, hi); }
        *(u32x4*)(ATT + row * AW + ck * 8) = o;
    }
}

constexpr int LRU_RAW = 0, LRU_RAWP = 272, LRU_XC = 18432, LRU_KC = 36864;

#define LRU_SCAN_STEP(DIR, N) \
    "v_fmac_f32_dpp %4, %4, %0 " DIR ":" #N " row_mask:0xf bank_mask:0xf\n\t" "v_fmac_f32_dpp %5, %5, %1 " DIR ":" #N " row_mask:0xf bank_mask:0xf\n\t" \
    "v_fmac_f32_dpp %6, %6, %2 " DIR ":" #N " row_mask:0xf bank_mask:0xf\n\t" "v_fmac_f32_dpp %7, %7, %3 " DIR ":" #N " row_mask:0xf bank_mask:0xf\n\t" \
    "v_mul_f32_dpp %0, %0, %0 " DIR ":" #N " row_mask:0xf bank_mask:0xf\n\t" "v_mul_f32_dpp %1, %1, %1 " DIR ":" #N " row_mask:0xf bank_mask:0xf\n\t" \
    "v_mul_f32_dpp %2, %2, %2 " DIR ":" #N " row_mask:0xf bank_mask:0xf\n\t" "v_mul_f32_dpp %3, %3, %3 " DIR ":" #N " row_mask:0xf bank_mask:0xf\n\t"
__device__ __forceinline__ void lru_scan4_fwd(f32x4& a, f32x4& h) {
    float a0 = a[0], a1 = a[1], a2 = a[2], a3 = a[3], h0 = h[0], h1 = h[1], h2 = h[2], h3 = h[3];
    asm volatile("s_nop 1\n\t" LRU_SCAN_STEP("row_shr", 1) LRU_SCAN_STEP("row_shr", 2) LRU_SCAN_STEP("row_shr", 4) LRU_SCAN_STEP("row_shr", 8) "s_nop 1"
                 : "+v"(a0), "+v"(a1), "+v"(a2), "+v"(a3), "+v"(h0), "+v"(h1), "+v"(h2), "+v"(h3));
    a = (f32x4){a0, a1, a2, a3}; h = (f32x4){h0, h1, h2, h3};
}
__device__ __forceinline__ void lru_scan4_bwd(f32x4& a, f32x4& h) {
    float a0 = a[0], a1 = a[1], a2 = a[2], a3 = a[3], h0 = h[0], h1 = h[1], h2 = h[2], h3 = h[3];
    asm volatile("s_nop 1\n\t" LRU_SCAN_STEP("row_shl", 1) LRU_SCAN_STEP("row_shl", 2) LRU_SCAN_STEP("row_shl", 4) LRU_SCAN_STEP("row_shl", 8) "s_nop 1"
                 : "+v"(a0), "+v"(a1), "+v"(a2), "+v"(a3), "+v"(h0), "+v"(h1), "+v"(h2), "+v"(h3));
    a = (f32x4){a0, a1, a2, a3}; h = (f32x4){h0, h1, h2, h3};
}
template <int PASS> __device__ __forceinline__ void phase_lru(LAS unsigned char* lds, const bf16_t* Z, const bf16_t* WL, float* LSUM, const float* LCAR, bf16_t* RNN,
                                                              int S, int tid, int lane, int wave, int G) {
    const int c = lane & 15, g4 = lane >> 4;
    const float* conv_w = ARGP(5); const float* conv_b = ARGP(6); const float* lba = ARGP(8); const float* lbx = ARGP(10); const float* lam = ARGP(11);
    for (int item = blockIdx.x; item < 12 * 64; item += G) {
        const int n = item >> 6, run = item & 63;
        const int ch0 = n * 128 + wave * 16 + 4 * g4;
        bf16x8 wf[4][4];
#pragma unroll
        for (int q = 0; q < 4; ++q)
#pragma unroll
            for (int s = 0; s < 4; ++s) wf[q][s] = *(const bf16x8*)(WL + ((size_t)((n * 4 + q) * 128 + wave * 16 + c)) * 128 + 32 * s + 8 * g4);
        LAS f32x4* kc = (LAS f32x4*)(lds + LRU_KC + wave * 11264);
#pragma unroll
        for (int k = 0; k < 4; ++k) kc[(6 + k) * 64 + lane] = *(const f32x4*)(conv_w + k * LW + ch0);
        kc[10 * 64 + lane] = *(const f32x4*)(conv_b + ch0);
#pragma unroll
        for (int d = 0; d < 2; ++d) { kc[(3 * d + 0) * 64 + lane] = *(const f32x4*)(lba + d * LW + ch0) * (-LOG2E); kc[(3 * d + 1) * 64 + lane] = *(const f32x4*)(lbx + d * LW + ch0) * (-LOG2E);
            const f32x4 lv = *(const f32x4*)(lam + d * LW + ch0); f32x4 sp;
#pragma unroll
            for (int j = 0; j < 4; ++j) sp[j] = -8.0f * LOG2E * log1pf(expf(-lv[j]));
            kc[(3 * d + 2) * 64 + lane] = sp; }
#define LRU_BAR() do { asm volatile("s_waitcnt lgkmcnt(0)" ::: "memory"); __builtin_amdgcn_s_barrier(); asm volatile("" ::: "memory"); } while (0)
        u32x4 rawr[3];
#define LRU_LOAD_RAW(SEG) { const int t0_ = (SEG) * 64, spos_ = t0_ & (S - 1); \
            _Pragma("unroll") for (int i = 0; i < 3; ++i) { const int idx = tid + 512 * i, rr = idx >> 4, chk = idx & 15, sp_ = spos_ - 2 + rr; \
                rawr[i] = (u32x4){0u, 0u, 0u, 0u}; \
                if (idx < 67 * 16 && sp_ >= 0 && sp_ < S) rawr[i] = *(const u32x4*)(Z + (size_t)(t0_ - 2 + rr) * DIN + C_RX + n * 128 + 8 * chk); } }
        LRU_LOAD_RAW(run * 4)
        for (int sg = 0; sg < 4; ++sg) {
            const int seg = run * 4 + sg, t0 = seg * 64;
#pragma unroll
            for (int i = 0; i < 3; ++i) { const int idx = tid + 512 * i; if (idx < 67 * 16) *(LAS u32x4*)(lds + LRU_RAW + (idx >> 4) * LRU_RAWP + 16 * (idx & 15)) = rawr[i]; }
            u32x2 ryr[4]; f32x4 car[2];
            if (PASS == 1) {
#pragma unroll
                for (int t = 0; t < 4; ++t) ryr[t] = *(const u32x2*)(Z + (size_t)(t0 + 16 * t + c) * DIN + C_RY + ch0);
                car[0] = *(const f32x4*)(LCAR + (size_t)(seg * 2 + 0) * LW + ch0); car[1] = *(const f32x4*)(LCAR + (size_t)(seg * 2 + 1) * LW + ch0);
            }
            LRU_BAR();
            f32x4 cw[4], cb;
#pragma unroll
            for (int k = 0; k < 4; ++k) cw[k] = kc[(6 + k) * 64 + lane];
            cb = kc[10 * 64 + lane];
            f32x4 xc[4];
#pragma unroll
            for (int t = 0; t < 4; ++t) { f32x4 acc = cb;
#pragma unroll
                for (int k = 0; k < 4; ++k) { const u32x2 rw = *(const LAS u32x2*)(lds + LRU_RAW + (16 * t + c + k) * LRU_RAWP + (wave * 16 + 4 * g4) * 2);
                    acc = acc + (f32x4){bflo(rw.x), bfhi(rw.x), bflo(rw.y), bfhi(rw.y)} * cw[k]; }
                xc[t] = acc;
                u32x2 w; w.x = pk2(acc[0], acc[1]); w.y = pk2(acc[2], acc[3]);
                *(LAS u32x2*)(lds + LRU_XC + off_b(16 * t + c, 2 * wave + (g4 >> 1)) + 8 * (g4 & 1)) = w; }
            LRU_BAR();
            if (sg + 1 < 4) LRU_LOAD_RAW(seg + 1)
            f32x4 hf[4];
            {
                f32x4 Hc = (f32x4){0.f, 0.f, 0.f, 0.f}, Ac = (f32x4){1.f, 1.f, 1.f, 1.f};
                if (PASS == 1) Hc = car[0];
#pragma unroll
                for (int t = 0; t < 4; ++t) {
                    f32x4 gr = (f32x4){0.f, 0.f, 0.f, 0.f}, gi = gr;
#pragma unroll
                    for (int s = 0; s < 4; ++s) { const bf16x8 bfr = *(const LAS bf16x8*)(lds + LRU_XC + off_b(16 * t + c, 4 * s + g4));
                        gr = __builtin_amdgcn_mfma_f32_16x16x32_bf16(wf[0][s], bfr, gr, 0, 0, 0); gi = __builtin_amdgcn_mfma_f32_16x16x32_bf16(wf[1][s], bfr, gi, 0, 0, 0); }
                    const f32x4 kba = kc[0 * 64 + lane], kbx = kc[1 * 64 + lane], ksp = kc[2 * 64 + lane];
                    f32x4 av, hv;
#pragma unroll
                    for (int j = 0; j < 4; ++j) {
                        const float rg = __builtin_amdgcn_rcpf(1.0f + __builtin_amdgcn_exp2f(fmaf(gr[j], -LOG2E, kba[j])));
                        const float ig = __builtin_amdgcn_rcpf(1.0f + __builtin_amdgcn_exp2f(fmaf(gi[j], -LOG2E, kbx[j])));
                        const float a_ = __builtin_amdgcn_exp2f(rg * ksp[j]);
                        av[j] = a_; hv[j] = __builtin_amdgcn_sqrtf(fmaf(-a_, a_, 1.0f)) * (ig * xc[t][j]);
                    }
                    lru_scan4_fwd(av, hv);
#pragma unroll
                    for (int j = 0; j < 4; ++j) {
                        const float hfull = fmaf(av[j], Hc[j], hv[j]);
                        if (PASS == 1) hf[t][j] = hfull;
                        Hc[j] = __shfl(hfull, (lane & 48) | 15);
                        if (PASS == 0) Ac[j] *= __shfl(av[j], (lane & 48) | 15);
                    }
                    __builtin_amdgcn_sched_barrier(0);
                }
                if (PASS == 0 && c == 0) {
#pragma unroll
                    for (int j = 0; j < 4; ++j) { float* sp = LSUM + ((size_t)(seg * 2 + 0) * LW + ch0 + j) * 2; sp[0] = Ac[j]; sp[1] = Hc[j]; }
                }
            }
            {
                f32x4 Hc = (f32x4){0.f, 0.f, 0.f, 0.f}, Ac = (f32x4){1.f, 1.f, 1.f, 1.f};
                if (PASS == 1) Hc = car[1];
#pragma unroll
                for (int tt = 0; tt < 4; ++tt) { const int t = 3 - tt;
                    f32x4 gr = (f32x4){0.f, 0.f, 0.f, 0.f}, gi = gr;
#pragma unroll
                    for (int s = 0; s < 4; ++s) { const bf16x8 bfr = *(const LAS bf16x8*)(lds + LRU_XC + off_b(16 * t + c, 4 * s + g4));
                        gr = __builtin_amdgcn_mfma_f32_16x16x32_bf16(wf[2][s], bfr, gr, 0, 0, 0); gi = __builtin_amdgcn_mfma_f32_16x16x32_bf16(wf[3][s], bfr, gi, 0, 0, 0); }
                    f32x4 ov;
                    const f32x4 kba = kc[3 * 64 + lane], kbx = kc[4 * 64 + lane], ksp = kc[5 * 64 + lane];
                    f32x4 av, hv;
#pragma unroll
                    for (int j = 0; j < 4; ++j) {
                        const float rg = __builtin_amdgcn_rcpf(1.0f + __builtin_amdgcn_exp2f(fmaf(gr[j], -LOG2E, kba[j])));
                        const float ig = __builtin_amdgcn_rcpf(1.0f + __builtin_amdgcn_exp2f(fmaf(gi[j], -LOG2E, kbx[j])));
                        const float a_ = __builtin_amdgcn_exp2f(rg * ksp[j]);
                        av[j] = a_; hv[j] = __builtin_amdgcn_sqrtf(fmaf(-a_, a_, 1.0f)) * (ig * xc[t][j]);
                    }
                    lru_scan4_bwd(av, hv);
#pragma unroll
                    for (int j = 0; j < 4; ++j) {
                        const float hfull = fmaf(av[j], Hc[j], hv[j]);
                        Hc[j] = __shfl(hfull, lane & 48);
                        if (PASS == 0) Ac[j] *= __shfl(av[j], lane & 48);
                        if (PASS == 1) { const unsigned rw = j < 2 ? ryr[t].x : ryr[t].y; const float y = (j & 1) ? bfhi(rw) : bflo(rw);
                            const float ge = y * __builtin_amdgcn_rcpf(1.0f + __builtin_amdgcn_exp2f((-2.3022082f * y) * fmaf(0.044715f * y, y, 1.0f)));
                            ov[j] = (hf[t][j] + hfull) * ge; }
                    }
                    if (PASS == 1) { u32x2 w; w.x = pk2(ov[0], ov[1]); w.y = pk2(ov[2], ov[3]); *(u32x2*)(RNN + (size_t)(t0 + 16 * t + c) * LW + ch0) = w; }
                    __builtin_amdgcn_sched_barrier(0);
                }
                if (PASS == 0 && c == 0) {
#pragma unroll
                    for (int j = 0; j < 4; ++j) { float* sp = LSUM + ((size_t)(seg * 2 + 1) * LW + ch0 + j) * 2; sp[0] = Ac[j]; sp[1] = Hc[j]; }
                }
            }
        }
#undef LRU_LOAD_RAW
#undef LRU_BAR
        __syncthreads();
    }
}
__device__ __forceinline__ void phase_lru_carry(const float* LSUM, float* LCAR, int S, int tid, int G) {
    const int nseq = CH / S, nseg = S / 64;
    for (int idx = blockIdx.x * 512 + tid; idx < nseq * 2 * LW; idx += G * 512) {
        const int ch = idx % LW, dir = (idx / LW) & 1, b = idx / (2 * LW);
        float H = 0.f;
        for (int i0 = 0; i0 < nseg; i0 += 8) {
            float A[8], h[8];
#pragma unroll
            for (int u = 0; u < 8; ++u) { const int i = i0 + u, s = dir ? nseg - 1 - i : i; const size_t o = (size_t)((b * nseg + s) * 2 + dir) * LW + ch;
                const float2 v = *(const float2*)(LSUM + o * 2); A[u] = v.x; h[u] = v.y; }
#pragma unroll
            for (int u = 0; u < 8; ++u) { const int i = i0 + u, s = dir ? nseg - 1 - i : i; const size_t o = (size_t)((b * nseg + s) * 2 + dir) * LW + ch;
                LCAR[o] = H; H = fmaf(A[u], H, h[u]); }
        }
    }
}

#ifndef REP_MASK
#define REP_MASK 0
#endif
#ifndef ONLY_K
#define EN(k) true
#else
#define EN(k) ((k) == ONLY_K)
#endif
__global__ void __launch_bounds__(512, 2) fwd_kernel(Args args) {
    extern __shared__ __attribute__((aligned(16))) unsigned char lds_raw[];
    LAS unsigned char* lds = (LAS unsigned char*)lds_raw;
    {
        LAS unsigned long long* pt = (LAS unsigned long long*)(lds + 131072);
        if (threadIdx.x == 0) {
#pragma unroll
            for (int i = 0; i < 19; ++i) pt[i] = (unsigned long long)args.in[i];
            pt[19] = (unsigned long long)args.out; pt[20] = (unsigned long long)args.ws;
        }
        if (threadIdx.x == 32) { ((LAS unsigned*)(lds + 131072 + 512))[0] = 0u; ((LAS unsigned*)(lds + 131072 + 512))[1] = 0u; }
        __syncthreads();
    }
    cg::grid_group grid = cg::this_grid();
    const bool ph_lo_neg = args.ph_lo < 0;
    XcdBarrier xbar = xcd_barrier_post((unsigned*)(GAS unsigned*)args.ws + 1024, (volatile LAS unsigned*)(lds + 131072 + 512));
    bool first_sync = (ph_lo_neg);
#define GRID_BAR() do { __syncthreads(); if (first_sync) { grid.sync(); first_sync = false; } else xcd_barrier(xbar); } while (0)

    const int ph_hi = args.ph_hi;
    for (int q = 2 * args.ph_lo; q < 2 * ph_hi; ++q) {
        const int p = q >> 1;
        if (REP_MASK == 0 && (q & 1)) continue;
        if (REP_MASK != 0 && (q & 1) && !((REP_MASK >> (p == 0 ? 9 : (p - 1) % NPH)) & 1)) { if (p + 1 < ph_hi) GRID_BAR(); continue; }
        int tid = threadIdx.x; asm volatile("" : "+v"(tid));
        const int lane = tid & 63, wave = __builtin_amdgcn_readfirstlane(tid >> 6);
        const int G = gridDim.x, gw = blockIdx.x * 8 + wave, NGW = G * 8;
        unsigned char* ws = (unsigned char*)(GAS unsigned char*)ldsptr(lds, 20);
        bf16_t* const WIN = (bf16_t*)(ws + WS_WIN); bf16_t* const WAO = (bf16_t*)(ws + WS_WAO); bf16_t* const WRO = (bf16_t*)(ws + WS_WRO); bf16_t* const WOUT = (bf16_t*)(ws + WS_WOUT);
        bf16_t* const W1 = (bf16_t*)(ws + WS_W1); bf16_t* const W2 = (bf16_t*)(ws + WS_W2); bf16_t* const WL = (bf16_t*)(ws + WS_WL);
        float* const SS = (float*)(ws + WS_SS); float* const RSTD = (float*)(ws + 524288); float* const LSUM = (float*)(ws + WS_LSUM); float* const LCAR = (float*)(ws + WS_LCAR); float* const LSE = (float*)(ws + WS_LSE);
        bf16_t* const XN = (bf16_t*)(ws + WS_XN); bf16_t* const ATT = (bf16_t*)(ws + WS_ATT); bf16_t* const RNN = (bf16_t*)(ws + WS_RNN); bf16_t* const OG = (bf16_t*)(ws + WS_OG);
        bf16_t* const MG = (bf16_t*)(ws + WS_MG); bf16_t* const X2B = (bf16_t*)(ws + WS_X2B); unsigned char* const G8 = ws + WS_G8; bf16_t* const Z = (bf16_t*)(ws + WS_Z); bf16_t* const HB = (bf16_t*)(ws + WS_Z);
        if (EN(9) && p == 0) {
            phase_weights(lds, ws, 0, gw, NGW, wave, lane); phase_weights(lds, ws, 1, gw, NGW, wave, lane);
            phase_xnorm(ARGP(0), ARGP(3), XN, gw, NGW, lane);
        } else {
            const int ck = (p - 1) / NPH, k = (p - 1) % NPH;
            const int S = ck < 2 ? 2048 : 4096;
            const float* xin = ck < 2 ? ARGP(0) + (size_t)ck * CH * DM : ARGP(1);
            float* out = (float*)ARGP(19) + (size_t)ck * CH * DM;
            if (EN(0) && k == 0) {
                pg8::Gemm g{XN, WIN, CH, DIN, DM}; pg8::StaticOrder So; So.init(CH, DIN, G, (int)blockIdx.x);
                pg8::EpiZ E{Z, G8};
                pg8::gemm_phase<pg8::EpiZ, pg8::StaticOrder, true, true>(lds, g, So, E);
                if ((int)blockIdx.x >= G / 2) { const int dgw = ((int)blockIdx.x - G / 2) * 8 + wave, DNGW = (G - G / 2) * 8;
                    if (ck > 0) phase_final_norm((float*)ARGP(19) + (size_t)(ck - 1) * CH * DM, X2B, SS, ARGP(18), dgw, DNGW, lane); }
            } else if (EN(1) && k == 1) {
#ifndef NO_LRU0
                phase_lru<0>(lds, Z, WL, LSUM, LCAR, RNN, S, tid, lane, wave, G);
                __syncthreads();
#endif
#ifndef NO_ATTN
                phase_attn(lds, Z, ARGP(2), OG, LSE, S, tid, lane, wave, G);
#endif
            } else if (EN(2) && k == 2) {
                phase_lru_carry(LSUM, LCAR, S, tid, G);
                phase_combine(OG, LSE, ATT, tid, G);
            } else if (EN(3) && k == 3) {
                phase_lru<1>(lds, Z, WL, LSUM, LCAR, RNN, S, tid, lane, wave, G);
            } else if (EN(4) && k == 4) {
                { pg8::Gemm g{ATT, WAO, CH, DM, AW}; pg8::StaticOrder So; So.init(CH, DM, G, (int)blockIdx.x);
                  pg8::EpiGate<false> E{G8, 0, (pg8::u32x4*)X2B, MG};
                  pg8::gemm_phase<pg8::EpiGate<false>, pg8::StaticOrder, true, true>(lds, g, So, E); }
                { pg8::Gemm g{RNN, WRO, CH, DM, LW}; pg8::StaticOrder So; So.init(CH, DM, G, (int)blockIdx.x);
                  pg8::EpiGate<true> E{G8, 8, (pg8::u32x4*)X2B, MG};
                  pg8::gemm_phase<pg8::EpiGate<true>, pg8::StaticOrder, true, true>(lds, g, So, E); }
            } else if (EN(5) && k == 5) {
                pg8::Gemm g{MG, WOUT, CH, DM, DM}; pg8::StaticOrder So; So.init(CH, DM, G, (int)blockIdx.x);
                pg8::EpiX1 E{xin, XN, SS};
                pg8::gemm_phase<pg8::EpiX1, pg8::StaticOrder, true, true>(lds, g, So, E);
            } else if (EN(6) && k == 6) {
                for (int row = (int)blockIdx.x * 512 + tid; row < CH; row += G * 512) { const f32x4* sp = (const f32x4*)(SS + (size_t)row * 32); float sm = 0.f;
#pragma unroll
                    for (int i = 0; i < 8; ++i) { const f32x4 t = sp[i]; sm += (t[0] + t[1]) + (t[2] + t[3]); }
                    RSTD[row] = 1.0f / sqrtf(sm * (1.0f / DM) + NORM_EPS); }
            } else if (EN(7) && k == 7) {
                pg8::Gemm g{XN, W1, CH, DFF, DM}; pg8::StaticOrder So; So.init(CH, DFF, G, (int)blockIdx.x);
                pg8::EpiMlpUp E{RSTD, HB};
                pg8::gemm_phase<pg8::EpiMlpUp, pg8::StaticOrder, true, true>(lds, g, So, E);
            } else if (EN(8) && k == 8) {
                pg8::Gemm g{HB, W2, CH, DM, DFF}; pg8::StaticOrder So; So.init(CH, DM, G, (int)blockIdx.x);
                pg8::EpiX2 E{XN, X2B, SS};
                pg8::gemm_phase<pg8::EpiX2, pg8::StaticOrder, true, true>(lds, g, So, E);
            } else if (EN(9)) {
                if (ck + 1 < NCH) { const float* xn = (ck + 1) < 2 ? ARGP(0) + (size_t)(ck + 1) * CH * DM : ARGP(1); phase_xnorm(xn, ARGP(3), XN, gw, NGW, lane); }
                else phase_final_norm(out, X2B, SS, ARGP(18), gw, NGW, lane);
            }
        }
        if (REP_MASK != 0 && !(q & 1)) { __syncthreads(); continue; }
        if (p + 1 < ph_hi) GRID_BAR();
    }
}

extern "C" void kernel_launch(void* const* d_in, const int* in_sizes, int n_in, void* d_out, int out_size, void* d_ws, size_t ws_size, hipStream_t stream) {
    static int grid = 0;
    if (grid == 0) {
        if (n_in != 19 || ws_size < WS_END) { fprintf(stderr, "kernel_launch: unexpected n_in %d / ws_size %zu\n", n_in, ws_size); grid = -1; return; }
        int dev = 0, cus = 0, per_cu = 0;
        hipGetDevice(&dev); hipDeviceGetAttribute(&cus, hipDeviceAttributeMultiprocessorCount, dev);
        if (hipFuncSetAttribute((const void*)fwd_kernel, hipFuncAttributeMaxDynamicSharedMemorySize, LDS_BYTES) != hipSuccess) { fprintf(stderr, "kernel_launch: hipFuncSetAttribute failed\n"); grid = -1; return; }
        hipOccupancyMaxActiveBlocksPerMultiprocessor(&per_cu, (const void*)fwd_kernel, 512, LDS_BYTES);
        (void)hipGetLastError();
        if (per_cu < 1) fprintf(stderr, "kernel_launch: occupancy query says %d blocks per CU\n", per_cu);
        grid = cus > 0 ? cus : 256;
    }
    if (grid < 0) return;
    if (hipMemsetAsync(d_ws, 0, 65536, stream) != hipSuccess) { fprintf(stderr, "kernel_launch: hipMemsetAsync failed\n"); return; }
    Args a{};
    for (int i = 0; i < 19; ++i) a.in[i] = (const float*)d_in[i];
    a.out = (float*)d_out; a.ws = (unsigned char*)d_ws;
#if MK_MULTI
    for (int p = 0; p < NPHASES; ++p) { a.ph_lo = p; a.ph_hi = p + 1; hipLaunchKernelGGL(fwd_kernel, dim3(grid), dim3(512), LDS_BYTES, stream, a); }
#else
    a.ph_lo = 0; a.ph_hi = NPHASES;
    void* kargs[] = {&a};
    hipError_t e = hipLaunchCooperativeKernel((const void*)fwd_kernel, dim3(grid), dim3(512), kargs, LDS_BYTES, stream);
    if (e != hipSuccess) fprintf(stderr, "kernel_launch: cooperative launch failed: %s (grid %d)\n", hipGetErrorString(e), grid);
#endif
}
```

```cpp
#include <hip/hip_runtime.h>
#include <hip/hip_cooperative_groups.h>
#include <cstdio>
#include <cstdint>
namespace cg = cooperative_groups;

#ifndef MK_MULTI
#define MK_MULTI 0
#endif

constexpr int DM = 2048, CH = 16384, NCH = 3;
constexpr int DIN = 11776;
constexpr int C_Q = 0, C_K = 1536, C_V = 3072, C_RX = 4608, C_RY = 6144, C_GA = 7680, C_GR = 9728;
constexpr int DFF = 8192, AW = 512, LW = 1536;
constexpr float NORM_EPS = 1e-6f;
constexpr float LOG2E = 1.4426950408889634f;
constexpr float QSCALE = 0.08838834764831845f * 1.4426950408889634f;

namespace pg8 {
#define PG8_LAS __attribute__((address_space(3)))
typedef unsigned short bf16_t;
typedef short bf16x8 __attribute__((ext_vector_type(8)));
typedef float f32x4 __attribute__((ext_vector_type(4)));
typedef unsigned u32x4 __attribute__((ext_vector_type(4)));
constexpr int BM = 256, BK = 64, HALF = 128, HTB = HALF * BK * 2  , STAGE_BYTES = 8 * HTB, NXCD = 8, WGM = 8;

__host__ __device__ __forceinline__ int lds_byte(int r, int c) { const int st = (r >> 4) * 2 + (c >> 5), rr = r & 15, cc = c & 31, ob = rr * 64 + cc * 2; return st * 1024 + (ob ^ (((ob >> 9) & 1) << 5)); }
__host__ __device__ __forceinline__ void stage_rc(int b, int& R, int& C) { const int st = b / 1024, sb = b % 1024, swz = sb ^ (((sb >> 9) & 1) << 5); R = (st >> 1) * 16 + swz / 64; C = (st & 1) * 32 + (swz % 64) / 2; }
__host__ __device__ __forceinline__ int perm32(int rho) { const int n = rho >> 4, i = rho & 15; return 8 * (i >> 2) + 4 * n + (i & 3); }

struct Unit { int pm, pn; };
struct Gemm { const bf16_t* A; const bf16_t* Bt; int M, N, K; };

struct StaticOrder {
    int nM, nN, nwg, G, c;
    __host__ __device__ void init(int M, int N, int G_, int c_) { nM = M / BM; nN = N / BM; nwg = nM * nN; G = G_; c = c_; }
    __host__ __device__ bool next(int i, Unit& u) const {
        const long L = (long)i * G + c; if (L >= nwg) return false;
        int wgid = (int)L; { const int q = nwg / NXCD, r = nwg % NXCD, xcd = wgid % NXCD, off = wgid / NXCD; wgid = (xcd < r ? xcd * (q + 1) : r * (q + 1) + (xcd - r) * q) + off; }
        const int nig = WGM * nN, gid = wgid / nig, fm = gid * WGM, gsz = (nM - fm) < WGM ? (nM - fm) : WGM;
        u.pm = fm + ((wgid % nig) % gsz); u.pn = (wgid % nig) / gsz; return true;
    }
    __device__ __forceinline__ void a_ready(const Unit&) const {}
    __device__ __forceinline__ void done(const Unit&) const {}
};

typedef float f32x2c_t __attribute__((ext_vector_type(2))); typedef __bf16 bf16x2c_t __attribute__((ext_vector_type(2)));
__device__ __forceinline__ unsigned cvt_pk_bf16(float lo, float hi) { const f32x2c_t v = {lo, hi}; const bf16x2c_t b = __builtin_convertvector(v, bf16x2c_t); return __builtin_bit_cast(unsigned, b); }
typedef float f32x2 __attribute__((ext_vector_type(2)));
typedef unsigned u32x2 __attribute__((ext_vector_type(2)));
__device__ __forceinline__ float sigmoidf_fast(float x) { return __builtin_amdgcn_rcpf(1.0f + __builtin_amdgcn_exp2f(-1.4426950408889634f * x)); }
__device__ __forceinline__ float bf_lo(unsigned w) { return __uint_as_float(w << 16); }
__device__ __forceinline__ float bf_hi(unsigned w) { return __uint_as_float(w & 0xffff0000u); }

struct EpiZ {
    static constexpr bool PERM = true, AFTER_DRAIN = false;
    bf16_t* Z; unsigned char* G8;
    __device__ __forceinline__ void operator()(const f32x4 (&acc)[2][2][4][2], const Unit& u, int wr, int wc, int fr, int fq) const {
        const int row0 = u.pm * BM + wr * 64 + fr, col0 = u.pn * BM + wc * 32 + 8 * fq;
        if (u.pn >= 30) {
            const int tidn = (wr * 4 + wc) * 64 + fq * 16 + fr;
            u32x4* gp = (u32x4*)G8 + (size_t)(u.pm * 16 + (u.pn - 30)) * 8 * 512 + tidn;
#pragma unroll
            for (int ai = 0; ai < 2; ++ai)
#pragma unroll
                for (int m = 0; m < 4; ++m) { unsigned q[16];
#pragma unroll
                    for (int bj = 0; bj < 2; ++bj) { const f32x4 v0 = acc[ai][bj][m][0], v1 = acc[ai][bj][m][1];
#pragma unroll
                        for (int e = 0; e < 4; ++e) { q[8 * bj + e] = (unsigned)fmaf(sigmoidf_fast(v0[e]), 255.0f, 0.5f); q[8 * bj + 4 + e] = (unsigned)fmaf(sigmoidf_fast(v1[e]), 255.0f, 0.5f); } }
                    u32x4 w; w.x = q[0] | (q[1] << 8) | (q[2] << 16) | (q[3] << 24); w.y = q[4] | (q[5] << 8) | (q[6] << 16) | (q[7] << 24);
                    w.z = q[8] | (q[9] << 8) | (q[10] << 16) | (q[11] << 24); w.w = q[12] | (q[13] << 8) | (q[14] << 16) | (q[15] << 24);
                    gp[(ai * 4 + m) * 512] = w; }
            return;
        }
        const bool qs = u.pn < 6;
#pragma unroll
        for (int ai = 0; ai < 2; ++ai)
#pragma unroll
            for (int m = 0; m < 4; ++m) { bf16_t* rowp = Z + (size_t)(row0 + ai * HALF + m * 16) * DIN + col0;
#pragma unroll
                for (int bj = 0; bj < 2; ++bj) { f32x4 v0 = acc[ai][bj][m][0], v1 = acc[ai][bj][m][1];
                    if (qs) { v0 = v0 * QSCALE; v1 = v1 * QSCALE; }
                    u32x4 w; w.x = cvt_pk_bf16(v0[0], v0[1]); w.y = cvt_pk_bf16(v0[2], v0[3]); w.z = cvt_pk_bf16(v1[0], v1[1]); w.w = cvt_pk_bf16(v1[2], v1[3]);
                    *(u32x4*)(rowp + bj * HALF) = w; } }
    }
};
template <bool SECOND> struct EpiGate {
    static constexpr bool PERM = true, AFTER_DRAIN = false;
    const unsigned char* G8; int gsel; u32x4* M1; bf16_t* MG;
    __device__ __forceinline__ void operator()(const f32x4 (&acc)[2][2][4][2], const Unit& u, int wr, int wc, int fr, int fq) const {
        const int row0 = u.pm * BM + wr * 64 + fr, col0 = u.pn * BM + wc * 32 + 8 * fq;
        const int tidn = (wr * 4 + wc) * 64 + fq * 16 + fr;
        const u32x4* gp = (const u32x4*)G8 + (size_t)(u.pm * 16 + gsel + u.pn) * 8 * 512 + tidn;
        u32x4* mp = M1 + (size_t)(u.pm * 8 + u.pn) * 16 * 512 + tidn;
        constexpr float K255 = 1.0f / 255.0f;
#pragma unroll
        for (int ai = 0; ai < 2; ++ai)
#pragma unroll
            for (int m = 0; m < 4; ++m) { const size_t row = (size_t)(row0 + ai * HALF + m * 16);
                const u32x4 gw = gp[(ai * 4 + m) * 512];
                u32x4 pw[2];
                if (SECOND) { pw[0] = mp[((ai * 4 + m) * 2 + 0) * 512]; pw[1] = mp[((ai * 4 + m) * 2 + 1) * 512]; }
#pragma unroll
                for (int bj = 0; bj < 2; ++bj) { const unsigned gx = bj ? gw.z : gw.x, gy = bj ? gw.w : gw.y;
                    const f32x4 g0 = (f32x4){(float)(gx & 255u), (float)((gx >> 8) & 255u), (float)((gx >> 16) & 255u), (float)(gx >> 24)} * K255,
                                g1 = (f32x4){(float)(gy & 255u), (float)((gy >> 8) & 255u), (float)((gy >> 16) & 255u), (float)(gy >> 24)} * K255;
                    f32x4 v0 = acc[ai][bj][m][0] * g0, v1 = acc[ai][bj][m][1] * g1;
                    if (SECOND) { const u32x4 p = pw[bj];
                        v0 = v0 + (f32x4){bf_lo(p.x), bf_hi(p.x), bf_lo(p.y), bf_hi(p.y)}; v1 = v1 + (f32x4){bf_lo(p.z), bf_hi(p.z), bf_lo(p.w), bf_hi(p.w)}; }
                    u32x4 w; w.x = cvt_pk_bf16(v0[0], v0[1]); w.y = cvt_pk_bf16(v0[2], v0[3]); w.z = cvt_pk_bf16(v1[0], v1[1]); w.w = cvt_pk_bf16(v1[2], v1[3]);
                    if (SECOND) *(u32x4*)(MG + row * DM + col0 + bj * HALF) = w; else mp[((ai * 4 + m) * 2 + bj) * 512] = w; }
                if (m == 3) asm volatile("" ::: "memory"); }
    }
};
struct EpiX1 {
    static constexpr bool PERM = true, AFTER_DRAIN = false;
    const float* base; bf16_t* XN; float* SS;
    __device__ __forceinline__ void operator()(const f32x4 (&acc)[2][2][4][2], const Unit& u, int wr, int wc, int fr, int fq) const {
        const int row0 = u.pm * BM + wr * 64 + fr, col0 = u.pn * BM + wc * 32 + 8 * fq;
#pragma unroll
        for (int ai = 0; ai < 2; ++ai)
#pragma unroll
            for (int m = 0; m < 4; ++m) { const size_t row = (size_t)(row0 + ai * HALF + m * 16); float ss = 0.f;
#pragma unroll
                for (int bj = 0; bj < 2; ++bj) { const size_t off = row * DM + col0 + bj * HALF;
                    f32x4 v0 = acc[ai][bj][m][0] + *(const f32x4*)(base + off), v1 = acc[ai][bj][m][1] + *(const f32x4*)(base + off + 4);
                    u32x4 w; w.x = cvt_pk_bf16(v0[0], v0[1]); w.y = cvt_pk_bf16(v0[2], v0[3]); w.z = cvt_pk_bf16(v1[0], v1[1]); w.w = cvt_pk_bf16(v1[2], v1[3]);
                    *(u32x4*)(XN + off) = w;
                    v0 = (f32x4){bf_lo(w.x), bf_hi(w.x), bf_lo(w.y), bf_hi(w.y)}; v1 = (f32x4){bf_lo(w.z), bf_hi(w.z), bf_lo(w.w), bf_hi(w.w)};
                    ss += (v0[0] * v0[0] + v0[1] * v0[1]) + (v0[2] * v0[2] + v0[3] * v0[3]) + (v1[0] * v1[0] + v1[1] * v1[1]) + (v1[2] * v1[2] + v1[3] * v1[3]); }
                ss += __shfl_xor(ss, 16); ss += __shfl_xor(ss, 32);
                if (fq == 0) SS[row * 32 + u.pn * 4 + wc] = ss; }
    }
};
struct EpiX2 {
    static constexpr bool PERM = true, AFTER_DRAIN = false;
    const bf16_t* XN; bf16_t* X2; float* SS;
    __device__ __forceinline__ void operator()(const f32x4 (&acc)[2][2][4][2], const Unit& u, int wr, int wc, int fr, int fq) const {
        const int row0 = u.pm * BM + wr * 64 + fr, col0 = u.pn * BM + wc * 32 + 8 * fq;
#pragma unroll
        for (int ai = 0; ai < 2; ++ai)
#pragma unroll
            for (int m = 0; m < 4; ++m) { const size_t row = (size_t)(row0 + ai * HALF + m * 16); float ss = 0.f;
#pragma unroll
                for (int bj = 0; bj < 2; ++bj) { const size_t off = row * DM + col0 + bj * HALF;
                    const u32x4 pw = *(const u32x4*)(XN + off);
                    f32x4 v0 = acc[ai][bj][m][0] + (f32x4){bf_lo(pw.x), bf_hi(pw.x), bf_lo(pw.y), bf_hi(pw.y)}, v1 = acc[ai][bj][m][1] + (f32x4){bf_lo(pw.z), bf_hi(pw.z), bf_lo(pw.w), bf_hi(pw.w)};
                    u32x4 w; w.x = cvt_pk_bf16(v0[0], v0[1]); w.y = cvt_pk_bf16(v0[2], v0[3]); w.z = cvt_pk_bf16(v1[0], v1[1]); w.w = cvt_pk_bf16(v1[2], v1[3]);
                    *(u32x4*)(X2 + off) = w;
                    v0 = (f32x4){bf_lo(w.x), bf_hi(w.x), bf_lo(w.y), bf_hi(w.y)}; v1 = (f32x4){bf_lo(w.z), bf_hi(w.z), bf_lo(w.w), bf_hi(w.w)};
                    ss += (v0[0] * v0[0] + v0[1] * v0[1]) + (v0[2] * v0[2] + v0[3] * v0[3]) + (v1[0] * v1[0] + v1[1] * v1[1]) + (v1[2] * v1[2] + v1[3] * v1[3]); }
                ss += __shfl_xor(ss, 16); ss += __shfl_xor(ss, 32);
                if (fq == 0) SS[row * 32 + u.pn * 4 + wc] = ss; }
    }
};
struct EpiMlpUp {
    static constexpr bool PERM = true, AFTER_DRAIN = false;
    const float* SS; bf16_t* H;
    __device__ __forceinline__ void operator()(const f32x4 (&acc)[2][2][4][2], const Unit& u, int wr, int wc, int fr, int fq) const {
        const int row0 = u.pm * BM + wr * 64 + fr, col0 = u.pn * BM + wc * 32 + 8 * fq;
#pragma unroll
        for (int ai = 0; ai < 2; ++ai)
#pragma unroll
            for (int m = 0; m < 4; ++m) { const size_t row = (size_t)(row0 + ai * HALF + m * 16);
                const f32x4* sp = (const f32x4*)(SS + row * 32) + 2 * fq; float s;
                { const f32x4 t0 = sp[0], t1 = sp[1]; s = ((t0[0] + t0[1]) + (t0[2] + t0[3])) + ((t1[0] + t1[1]) + (t1[2] + t1[3])); }
                s += __shfl_xor(s, 16); s += __shfl_xor(s, 32);
                const float rstd = 1.0f / sqrtf(s * (1.0f / DM) + NORM_EPS);
#pragma unroll
                for (int bj = 0; bj < 2; ++bj) { f32x4 v0 = acc[ai][bj][m][0] * rstd, v1 = acc[ai][bj][m][1] * rstd;
#pragma unroll
                    for (int e = 0; e < 4; ++e) { const float a = fmaxf(v0[e], 0.f), b = fmaxf(v1[e], 0.f); v0[e] = a * a; v1[e] = b * b; }
                    u32x4 w; w.x = cvt_pk_bf16(v0[0], v0[1]); w.y = cvt_pk_bf16(v0[2], v0[3]); w.z = cvt_pk_bf16(v1[0], v1[1]); w.w = cvt_pk_bf16(v1[2], v1[3]);
                    *(u32x4*)(H + row * DFF + col0 + bj * HALF) = w; } }
    }
};

template <class Epi, class Sched, bool ALIGN_EPI = false, bool SP2 = false>
__device__ __forceinline__ void gemm_phase(PG8_LAS unsigned char* lds, const Gemm g, const Sched& S, const Epi& E) {
    int tid_ = threadIdx.x; asm volatile("" : "+v"(tid_));
    const int tid = tid_, wid = __builtin_amdgcn_readfirstlane(tid >> 6), lane = tid & 63, wr = wid >> 2, wc = wid & 3, fr = lane & 15, fq = lane >> 4;
    const int K = g.K, nt = K / BK;
    unsigned voffA[2], voffB[2];
#pragma unroll
    for (int i = 0; i < 2; ++i) { int R, C; stage_rc(tid * 16 + i * 8192, R, C); const int Rb = Epi::PERM ? ((R & ~31) + perm32(R & 31)) : R;
        voffA[i] = (unsigned)(R * K + C) * 2u; voffB[i] = (unsigned)(Rb * K + C) * 2u; }
    const size_t kstep = (size_t)(BK * 2);
    const size_t hstep = (size_t)HALF * K * 2;
    const size_t tstep = 2 * hstep;
    const unsigned ldsw = (unsigned)wid * 1024u;
    const int aoff = lds_byte(wr * 64 + fr, fq * 8), boff = lds_byte(wc * 32 + fr, fq * 8);
#define PG8_SA(b, h) (((b) * 2 + (h)) * HTB)
#define PG8_SB(b, h) ((4 + (b) * 2 + (h)) * HTB)
#define PG8_STAGE(bufoff, gbase, voff) do { _Pragma("unroll") for (int _i = 0; _i < 2; ++_i) \
        __builtin_amdgcn_global_load_lds((const unsigned*)((const char*)(gbase) + (voff)[_i]), (PG8_LAS unsigned*)(lds + (bufoff) + ldsw + _i * 8192), 16, 0, 0); } while (0)
#define PG8_LDA(dst, b, h) do { _Pragma("unroll") for (int m = 0; m < 4; ++m) _Pragma("unroll") for (int k = 0; k < 2; ++k) dst[m][k] = *(const PG8_LAS bf16x8*)(lds + PG8_SA(b, h) + aoff + m * 2048 + k * 1024); } while (0)
#define PG8_LDB(dst, b, h) do { _Pragma("unroll") for (int n = 0; n < 2; ++n) _Pragma("unroll") for (int k = 0; k < 2; ++k) dst[n][k] = *(const PG8_LAS bf16x8*)(lds + PG8_SB(b, h) + boff + n * 2048 + k * 1024); } while (0)
#define PG8_MMA(ai, bj, At, Bt) do { __builtin_amdgcn_s_setprio(1); _Pragma("unroll") for (int m = 0; m < 4; ++m) _Pragma("unroll") for (int n = 0; n < 2; ++n) _Pragma("unroll") for (int k = 0; k < 2; ++k) \
        acc[ai][bj][m][n] = __builtin_amdgcn_mfma_f32_16x16x32_bf16(Bt[n][k], At[m][k], acc[ai][bj][m][n], 0, 0, 0); __builtin_amdgcn_s_setprio(0); } while (0)
#define PG8_WAIT_V(n) asm volatile("s_waitcnt vmcnt(" #n ")" ::: "memory")
#define PG8_WAIT_L(n) asm volatile("s_waitcnt lgkmcnt(" #n ")" ::: "memory")
#define PG8_BAR __builtin_amdgcn_s_barrier()
#define PG8_SCHED __builtin_amdgcn_sched_barrier(0)
    Unit cur, nxt; int ui = 0;
    if (!S.next(0, cur)) return;
    f32x4 acc[2][2][4][2];
#pragma unroll
    for (int a = 0; a < 2; ++a)
#pragma unroll
        for (int b = 0; b < 2; ++b)
#pragma unroll
            for (int m = 0; m < 4; ++m)
#pragma unroll
                for (int n = 0; n < 2; ++n) acc[a][b][m][n] = (f32x4){0.f, 0.f, 0.f, 0.f};
    bf16x8 At[4][2], B0[2][2], B1[2][2];
    const char* cA = (const char*)g.A + (size_t)cur.pm * tstep; const char* cB = (const char*)g.Bt + (size_t)cur.pn * tstep;
    S.a_ready(cur);
    if constexpr (SP2) {
        PG8_STAGE(PG8_SB(0, 0), cB, voffB); PG8_STAGE(PG8_SB(0, 1), cB + hstep, voffB); PG8_STAGE(PG8_SA(0, 0), cA, voffA); PG8_STAGE(PG8_SA(0, 1), cA + hstep, voffA);
        if (wr == 1) PG8_BAR;
        PG8_WAIT_V(2); PG8_BAR;
        PG8_STAGE(PG8_SB(1, 0), cB + kstep, voffB); PG8_STAGE(PG8_SA(1, 0), cA + kstep, voffA); PG8_STAGE(PG8_SB(1, 1), cB + hstep + kstep, voffB);
        PG8_WAIT_V(6); PG8_BAR;
    } else {
        PG8_STAGE(PG8_SB(0, 0), cB, voffB); PG8_STAGE(PG8_SA(0, 0), cA, voffA); PG8_STAGE(PG8_SB(0, 1), cB + hstep, voffB); PG8_STAGE(PG8_SA(0, 1), cA + hstep, voffA);
        if (wr == 1) PG8_BAR;
        PG8_WAIT_V(4); PG8_BAR;
        PG8_STAGE(PG8_SB(1, 0), cB + kstep, voffB); PG8_STAGE(PG8_SA(1, 0), cA + kstep, voffA); PG8_STAGE(PG8_SB(1, 1), cB + hstep + kstep, voffB);
        PG8_WAIT_V(6); PG8_BAR;
    }
    for (;;) {
        const bool has_next = S.next(ui + 1, nxt);
        const char* nA = has_next ? (const char*)g.A + (size_t)nxt.pm * tstep : cA; const char* nB = has_next ? (const char*)g.Bt + (size_t)nxt.pn * tstep : cB;
        for (int t = 0; t < nt; t += 2) {
            const bool last = (t == nt - 2);
            const char* a1 = cA + (size_t)(t + 1) * kstep;
            const char* a2 = last ? nA : cA + (size_t)(t + 2) * kstep; const char* b2 = last ? nB : cB + (size_t)(t + 2) * kstep;
            const char* a3 = a2 + kstep; const char* b3 = b2 + kstep;
            if (last && has_next) S.a_ready(nxt);
            if constexpr (SP2) {
            PG8_LDB(B0, 0, 0); PG8_LDB(B1, 0, 1); PG8_SCHED; PG8_LDA(At, 0, 0); PG8_STAGE(PG8_SA(1, 1), a1 + hstep, voffA);
            PG8_WAIT_V(8); PG8_WAIT_L(0); PG8_BAR; PG8_MMA(0, 0, At, B0); PG8_MMA(0, 1, At, B1); PG8_BAR; PG8_SCHED;
            PG8_LDA(At, 0, 1); PG8_STAGE(PG8_SB(0, 0), b2, voffB); PG8_STAGE(PG8_SB(0, 1), b2 + hstep, voffB); PG8_STAGE(PG8_SA(0, 0), a2, voffA);
            PG8_WAIT_V(8); PG8_WAIT_L(0); PG8_BAR; PG8_MMA(1, 0, At, B0); PG8_MMA(1, 1, At, B1); PG8_BAR; PG8_SCHED;
            PG8_LDB(B0, 1, 0); PG8_LDB(B1, 1, 1); PG8_SCHED; PG8_LDA(At, 1, 0); PG8_STAGE(PG8_SA(0, 1), a2 + hstep, voffA);
            PG8_WAIT_V(8); PG8_WAIT_L(0); PG8_BAR; PG8_MMA(0, 0, At, B0); PG8_MMA(0, 1, At, B1); PG8_BAR; PG8_SCHED;
            PG8_LDA(At, 1, 1); PG8_STAGE(PG8_SB(1, 0), b3, voffB); PG8_STAGE(PG8_SB(1, 1), b3 + hstep, voffB); PG8_STAGE(PG8_SA(1, 0), a3, voffA);
            PG8_WAIT_V(8); PG8_WAIT_L(0); PG8_BAR; PG8_MMA(1, 0, At, B0); PG8_MMA(1, 1, At, B1); PG8_BAR; PG8_SCHED;
            } else {
            PG8_LDB(B0, 0, 0); PG8_SCHED; PG8_LDA(At, 0, 0); PG8_STAGE(PG8_SA(1, 1), a1 + hstep, voffA);
            PG8_WAIT_L(8); PG8_BAR; PG8_WAIT_L(0); PG8_MMA(0, 0, At, B0); PG8_BAR; PG8_SCHED;
            PG8_LDB(B1, 0, 1); PG8_STAGE(PG8_SB(0, 0), b2, voffB);
            PG8_BAR; PG8_WAIT_L(0); PG8_MMA(0, 1, At, B1); PG8_BAR;
            PG8_LDA(At, 0, 1); PG8_STAGE(PG8_SA(0, 0), a2, voffA);
            PG8_BAR; PG8_WAIT_L(0); PG8_MMA(1, 0, At, B0); PG8_BAR; PG8_SCHED;
            PG8_STAGE(PG8_SB(0, 1), b2 + hstep, voffB);
            PG8_WAIT_V(6); PG8_BAR; PG8_MMA(1, 1, At, B1); PG8_BAR;
            PG8_LDB(B0, 1, 0); PG8_SCHED; PG8_LDA(At, 1, 0); PG8_STAGE(PG8_SA(0, 1), a2 + hstep, voffA);
            PG8_WAIT_L(8); PG8_BAR; PG8_WAIT_L(0); PG8_MMA(0, 0, At, B0); PG8_BAR; PG8_SCHED;
            PG8_LDB(B1, 1, 1); PG8_STAGE(PG8_SB(1, 0), b3, voffB);
            PG8_BAR; PG8_WAIT_L(0); PG8_MMA(0, 1, At, B1); PG8_BAR;
            PG8_LDA(At, 1, 1); PG8_STAGE(PG8_SA(1, 0), a3, voffA);
            PG8_BAR; PG8_WAIT_L(0); PG8_MMA(1, 0, At, B0); PG8_BAR; PG8_SCHED;
            PG8_STAGE(PG8_SB(1, 1), b3 + hstep, voffB);
            PG8_WAIT_V(6); PG8_BAR; PG8_MMA(1, 1, At, B1); PG8_BAR;
            }
        }
        if constexpr (ALIGN_EPI) { if (wr == 0) PG8_BAR; }
        if constexpr (!Epi::AFTER_DRAIN) { E(acc, cur, wr, wc, fr, fq); S.done(cur); }
        if (!has_next) break;
#pragma unroll
        for (int a = 0; a < 2; ++a)
#pragma unroll
            for (int b = 0; b < 2; ++b)
#pragma unroll
                for (int m = 0; m < 4; ++m)
#pragma unroll
                    for (int n = 0; n < 2; ++n) acc[a][b][m][n] = (f32x4){0.f, 0.f, 0.f, 0.f};
        cur = nxt; cA = nA; cB = nB; ++ui;
        if constexpr (ALIGN_EPI) { if (wr == 1) PG8_BAR; }
    }
    PG8_WAIT_V(0);
    if constexpr (!ALIGN_EPI) { if (wr == 0) PG8_BAR; }
    PG8_BAR;
    if constexpr (Epi::AFTER_DRAIN) { E.fused(acc, cur, wr, wc, fr, fq, lds, wid, lane); S.done(cur); }
#undef PG8_SA
#undef PG8_SB
#undef PG8_STAGE
#undef PG8_LDA
#undef PG8_LDB
#undef PG8_MMA
#undef PG8_WAIT_V
#undef PG8_WAIT_L
#undef PG8_BAR
#undef PG8_SCHED
}
}

constexpr size_t MiB = (size_t)1 << 20;
constexpr size_t WS_CTL = 0;
constexpr size_t WS_WIN = 1 * MiB;
constexpr size_t WS_WAO = 47 * MiB;
constexpr size_t WS_WRO = 49 * MiB;
constexpr size_t WS_WOUT = 55 * MiB;
constexpr size_t WS_W1 = 63 * MiB;
constexpr size_t WS_W2 = 95 * MiB;
constexpr size_t WS_WL = 127 * MiB;
constexpr size_t WS_SS = 129 * MiB;
constexpr size_t WS_LSUM = 131 * MiB;
constexpr size_t WS_LCAR = 137 * MiB;
constexpr size_t WS_LSE = 140 * MiB;
constexpr size_t WS_XN = 141 * MiB;
constexpr size_t WS_ATT = 205 * MiB;
constexpr size_t WS_RNN = 221 * MiB;
constexpr size_t WS_OG = 269 * MiB;
constexpr size_t WS_MG = 317 * MiB;
constexpr size_t WS_G8 = 445 * MiB;
constexpr size_t WS_X2B = 381 * MiB;
constexpr size_t WS_Z = 509 * MiB;
constexpr size_t WS_END = 877 * MiB;

constexpr int LDS_BYTES = 131072 + 16384;
constexpr int NPH = 9;
constexpr int NPHASES = 1 + NCH * NPH;

#define LAS __attribute__((address_space(3)))
typedef unsigned short bf16_t;
typedef short bf16x8 __attribute__((ext_vector_type(8)));
typedef short s16x4 __attribute__((ext_vector_type(4)));
typedef float f32x4 __attribute__((ext_vector_type(4)));
typedef unsigned u32x4 __attribute__((ext_vector_type(4)));
typedef unsigned u32x2 __attribute__((ext_vector_type(2)));
#define LDS_WAIT() asm volatile("s_waitcnt lgkmcnt(0)" ::: "memory")

__device__ __forceinline__ unsigned pk2(float lo, float hi) { return pg8::cvt_pk_bf16(lo, hi); }
__device__ __forceinline__ float bflo(unsigned w) { return __uint_as_float(w << 16); }
__device__ __forceinline__ float bfhi(unsigned w) { return __uint_as_float(w & 0xffff0000u); }
__device__ __forceinline__ float wave_sum(float v) {
#pragma unroll
    for (int o = 1; o < 64; o <<= 1) v += __shfl_xor(v, o);
    return v;
}
__device__ __forceinline__ float fast_sigmoid(float x) { return __builtin_amdgcn_rcpf(1.0f + __builtin_amdgcn_exp2f(-LOG2E * x)); }
__device__ __forceinline__ unsigned off_b(unsigned row, unsigned ch) { return 256u * row + 16u * (ch ^ (((row & 3u) << 2) | ((row >> 2) & 3u))); }
__device__ __forceinline__ s16x4 ldtr(LAS const unsigned char* p) { return __builtin_bit_cast(s16x4, __builtin_amdgcn_ds_read_tr16_b64_v4i16((LAS s16x4*)p)); }
template <int CTRL> __device__ __forceinline__ float dpp_f(float old, float v) {
    return __int_as_float(__builtin_amdgcn_update_dpp(__float_as_int(old), __float_as_int(v), CTRL, 0xf, 0xf, false));
}

struct Args { const float* in[19]; float* out; unsigned char* ws; int ph_lo, ph_hi; };
__device__ __forceinline__ unsigned long long ldsptr(LAS unsigned char* lds, int i) {
    const LAS unsigned* p = (const LAS unsigned*)(lds + 131072 + 8 * i);
    const unsigned lo = __builtin_amdgcn_readfirstlane(p[0]), hi = __builtin_amdgcn_readfirstlane(p[1]);
    return ((unsigned long long)hi << 32) | lo;
}
#define GAS __attribute__((address_space(1)))
#define ARGP(i) ((const float*)(GAS const float*)ldsptr(lds, (i)))

#define XB_TMO      128
#define XB_XCNT(j)  (256  + 64 * (j))
#define XB_XSUB(j)  (1280 + 64 * (j))
#define XB_XGEN(j)  (2304 + 64 * (j))
#define XB_TOP      3328
#define XB_TOPGEN   3392
#define XCD_BAR_WORDS 3456
#define XB_SPIN_CAP (1u << 18)

__device__ __forceinline__ unsigned xb_ld(unsigned* p)              { return __hip_atomic_load(p, __ATOMIC_RELAXED, __HIP_MEMORY_SCOPE_AGENT); }
__device__ __forceinline__ unsigned xb_add(unsigned* p, unsigned v) { return __hip_atomic_fetch_add(p, v, __ATOMIC_RELAXED, __HIP_MEMORY_SCOPE_AGENT); }
__device__ __forceinline__ unsigned xb_xcc_id() { return (unsigned)__builtin_amdgcn_s_getreg((3 << 11) | 20) & 0xFu; }
#define XB_SPIN(cond, bar) do { unsigned _sp = 0; while (cond) { __builtin_amdgcn_s_sleep(1); \
    if ((++_sp & 255u) == 0u) { if (xb_ld(&(bar)[XB_TMO])) break; if (_sp > XB_SPIN_CAP) { atomicAdd(&(bar)[XB_TMO], 1u); break; } } } } while (0)

struct XcdBarrier {
    unsigned* bar; unsigned x;
    volatile LAS unsigned* st;
};

__device__ __forceinline__ XcdBarrier xcd_barrier_post(unsigned* bar, volatile LAS unsigned* st) {
    XcdBarrier b; b.bar = bar; b.x = xb_xcc_id(); b.st = st;
    if (threadIdx.x == 0) (void)xb_add(&bar[XB_XCNT(b.x)], 1u);
    return b;
}
__device__ __forceinline__ void xcd_barrier_complete(unsigned* bar, unsigned x, unsigned& nloc, unsigned& nx) {
    const unsigned G = gridDim.x * gridDim.y * gridDim.z;
    unsigned sum, cnt, mine, sp = 0u;
    for (;;) {
        sum = 0u; cnt = 0u; mine = 0u;
#pragma unroll
        for (unsigned j = 0; j < 16; ++j) { const unsigned c = xb_ld(&bar[XB_XCNT(j)]); sum += c; cnt += (c > 0u) ? 1u : 0u; mine = (j == x) ? c : mine; }
        if (sum == G) break;
        __builtin_amdgcn_s_sleep(1);
        if ((++sp & 255u) == 0u) { if (xb_ld(&bar[XB_TMO])) break; if (sp > XB_SPIN_CAP) { atomicAdd(&bar[XB_TMO], 1u); break; } }
    }
    nloc = mine > 0u ? mine : 1u; nx = cnt > 0u ? cnt : 1u;
}

__device__ __forceinline__ void xcd_barrier(const XcdBarrier& b) {
    asm volatile("s_waitcnt vmcnt(0)" ::: "memory");
    __syncthreads();
    if (threadIdx.x == 0) {
        unsigned* bar = b.bar;
        __builtin_amdgcn_s_waitcnt(0);
        unsigned nloc = b.st[0], nx = b.st[1];
        if (nloc == 0u) { xcd_barrier_complete(bar, b.x, nloc, nx); b.st[0] = nloc; b.st[1] = nx; }
        const unsigned old = xb_add(&bar[XB_XSUB(b.x)], 1u);
        const unsigned gen = old / nloc;
        if (old + 1u == (gen + 1u) * nloc) {
            __builtin_amdgcn_fence(__ATOMIC_RELEASE, "agent");
            asm volatile("s_waitcnt vmcnt(0)" ::: "memory");
            const unsigned og = xb_add(&bar[XB_TOP], 1u);
            const unsigned tg = og / nx;
            if (og + 1u == (tg + 1u) * nx) xb_add(&bar[XB_TOPGEN], 1u);
            else XB_SPIN(xb_ld(&bar[XB_TOPGEN]) == tg, bar);
            __builtin_amdgcn_fence(__ATOMIC_ACQUIRE, "agent");
            xb_add(&bar[XB_XGEN(b.x)], 1u);
            asm volatile("s_waitcnt vmcnt(0)" ::: "memory");
        } else {
            XB_SPIN(xb_ld(&bar[XB_XGEN(b.x)]) == gen, bar);
            __builtin_amdgcn_fence(__ATOMIC_ACQUIRE, "agent");
            asm volatile("s_waitcnt vmcnt(0)" ::: "memory");
        }
    }
    __syncthreads();
}

__device__ __forceinline__ void transpose_item(const float* W, int K, int N, bf16_t* WT, const float* ksc, LAS float* scr, int item, int lane) {
    const int nblk = N / 32, kb = item / nblk, nb = item % nblk, k0 = 64 * kb, n0 = 32 * nb;
#pragma unroll
    for (int i = 0; i < 8; ++i) { const int kk = 8 * i + (lane >> 3), c4 = 4 * (lane & 7);
        f32x4 v = *(const f32x4*)(W + (size_t)(k0 + kk) * N + n0 + c4); if (ksc) v = v * ksc[k0 + kk];
        LAS float* d = scr + kk * 33 + c4; d[0] = v[0]; d[1] = v[1]; d[2] = v[2]; d[3] = v[3]; }
    LDS_WAIT(); asm volatile("" ::: "memory");
    const int c = lane & 7;
#pragma unroll
    for (int j = 0; j < 4; ++j) { const int n = (lane >> 3) + 8 * j; const LAS float* s = scr + (8 * c) * 33 + n;
        u32x4 o; o.x = pk2(s[0 * 33], s[1 * 33]); o.y = pk2(s[2 * 33], s[3 * 33]); o.z = pk2(s[4 * 33], s[5 * 33]); o.w = pk2(s[6 * 33], s[7 * 33]);
        *(u32x4*)(WT + (size_t)(n0 + n) * K + k0 + 8 * c) = o; }
    LDS_WAIT(); asm volatile("" ::: "memory");
}
__device__ __forceinline__ void phase_weights(LAS unsigned char* lds, unsigned char* ws, int part, int gw, int NGW, int wave, int lane) {
    LAS float* scr = (LAS float*)(lds + wave * 16384);
    constexpr int I_IN = (DM / 64) * (DIN / 32), I_AO = (AW / 64) * (DM / 32), I_RO = (LW / 64) * (DM / 32), I_OUT = (DM / 64) * (DM / 32),
                  I_1 = (DM / 64) * (DFF / 32), I_2 = (DFF / 64) * (DM / 32), I_L = 48 * 8;
    constexpr int NITEMS = I_IN + I_AO + I_RO + I_OUT + I_1 + I_2 + I_L;
    constexpr int NPART0 = I_IN + I_L, NPART1 = NITEMS - NPART0;
    for (int jt = gw; jt < (part == 0 ? NPART0 : NPART1); jt += NGW) {
        const int it = part == 0 ? (jt < I_IN ? jt : jt - I_IN + (NITEMS - I_L)) : jt + I_IN;
        int r = it;
        if (r < I_IN) { transpose_item(ARGP(4), DM, DIN, (bf16_t*)(ws + WS_WIN), nullptr, scr, r, lane); continue; } r -= I_IN;
        if (r < I_AO) { transpose_item(ARGP(12), AW, DM, (bf16_t*)(ws + WS_WAO), nullptr, scr, r, lane); continue; } r -= I_AO;
        if (r < I_RO) { transpose_item(ARGP(13), LW, DM, (bf16_t*)(ws + WS_WRO), nullptr, scr, r, lane); continue; } r -= I_RO;
        if (r < I_OUT) { transpose_item(ARGP(14), DM, DM, (bf16_t*)(ws + WS_WOUT), nullptr, scr, r, lane); continue; } r -= I_OUT;
        if (r < I_1) { transpose_item(ARGP(16), DM, DFF, (bf16_t*)(ws + WS_W1), ARGP(15), scr, r, lane); continue; } r -= I_1;
        if (r < I_2) { transpose_item(ARGP(17), DFF, DM, (bf16_t*)(ws + WS_W2), nullptr, scr, r, lane); continue; } r -= I_2;
        {
            const int mi = r >> 3, sub = r & 7, q = mi / 12, n = mi % 12, dir = q >> 1, type = q & 1;
            const float* src = (type ? ARGP(9) : ARGP(7)) + (size_t)(dir * 12 + n) * 128 * 128;
            transpose_item(src, 128, 128, (bf16_t*)(ws + WS_WL) + (size_t)(n * 4 + q) * 128 * 128, nullptr, scr, sub, lane);
        }
    }
}
__device__ __forceinline__ void phase_xnorm(const float* x, const float* gain, bf16_t* XN, int gw, int NGW, int lane) {
    for (int m = gw; m < CH; m += NGW) {
        const f32x4* xr = (const f32x4*)(x + (size_t)m * DM) + lane;
        f32x4 v[8]; float s = 0.f;
#pragma unroll
        for (int j = 0; j < 8; ++j) { v[j] = xr[64 * j]; s += (v[j][0] * v[j][0] + v[j][1] * v[j][1]) + (v[j][2] * v[j][2] + v[j][3] * v[j][3]); }
        const float rstd = 1.0f / sqrtf(wave_sum(s) * (1.0f / DM) + NORM_EPS);
        u32x2* o = (u32x2*)(XN + (size_t)m * DM) + lane;
#pragma unroll
        for (int j = 0; j < 8; ++j) { const f32x4 g = ((const f32x4*)gain)[64 * j + lane]; const f32x4 y = v[j] * rstd * g;
            u32x2 w; w.x = pk2(y[0], y[1]); w.y = pk2(y[2], y[3]); o[64 * j] = w; }
    }
}
__device__ __forceinline__ void phase_final_norm(float* out, const bf16_t* X2, const float* SS, const float* gain, int gw, int NGW, int lane) {
    for (int m = gw; m < CH; m += NGW) {
        const float p = lane < 32 ? SS[(size_t)m * 32 + lane] : 0.f;
        const u32x2* xr = (const u32x2*)(X2 + (size_t)m * DM) + lane;
        u32x2 xv[8];
#pragma unroll
        for (int j = 0; j < 8; ++j) xv[j] = xr[64 * j];
        const float rstd = 1.0f / sqrtf(wave_sum(p) * (1.0f / DM) + NORM_EPS);
        f32x4* o = (f32x4*)(out + (size_t)m * DM) + lane;
#pragma unroll
        for (int j = 0; j < 8; ++j) { const f32x4 g = ((const f32x4*)gain)[64 * j + lane];
            o[64 * j] = (f32x4){bflo(xv[j].x), bfhi(xv[j].x), bflo(xv[j].y), bfhi(xv[j].y)} * rstd * g; }
    }
}

constexpr int ATT_TAB = 131072 + 2048;
__device__ __forceinline__ void phase_attn(LAS unsigned char* lds, const bf16_t* Z, const float* rel_bias, bf16_t* OG, float* LSE, int S, int tid, int lane, int wave, int G) {
    LAS float* tab = (LAS float*)(lds + ATT_TAB);
    for (int e = tid; e < 12 * 192; e += 512) {
        const int hh = e / 192, ri = e % 192, rel = ri - 95, gg = hh >> 2, dist = rel * (1 << (2 * gg));
        const int n = dist < 0 ? -dist : dist; const float nf = (float)(n < 1 ? 1 : n);
        int large = 8 + (int)(logf(nf / 8.0f) / logf(128.0f) * 8.0f); large = large < 15 ? large : 15;
        const int bucket = (dist > 0 ? 16 : 0) + (n < 8 ? n : large);
        tab[e] = (rel >= -64 && rel <= 64) ? rel_bias[bucket * 12 + hh] * LOG2E : -1e30f;
    }
    __syncthreads();
    const int c = lane & 15, g4 = lane >> 4, tq = c >> 2, tp = c & 3;
    constexpr int PER_GRP = CH * 4 / 128;
    for (int item = blockIdx.x; item < 3 * PER_GRP; item += G) {
        const int grp = item / PER_GRP; int idx = item % PER_GRP;
        const int sh = 2 * grp, L = S >> sh, nblk = L >> 7;
        const int blk = idx % nblk; idx /= nblk; const int h = idx & 3; idx >>= 2; const int r = idx & ((1 << sh) - 1); const int b = idx >> sh;
        const int head = grp * 4 + h, i0 = blk * 128;
        const size_t rowbase = (size_t)b * S + r;
        const bf16_t* Zq = Z + C_Q + head * 128; const bf16_t* Zk = Z + C_K + head * 128; const bf16_t* Zv = Z + C_V + head * 128;
#pragma unroll
        for (int q = 0; q < 8; ++q) {
            const int br = 32 * wave + 4 * q + (lane >> 4); int fi = i0 - 64 + br; fi = fi < 0 ? 0 : (fi > L - 1 ? L - 1 : fi);
            const int ch = (lane & 15) ^ (((br & 3) << 2) | ((br >> 2) & 3));
            const size_t go = (rowbase + ((size_t)fi << sh)) * DIN + 8 * ch;
            __builtin_amdgcn_global_load_lds((const unsigned*)(Zk + go), (LAS unsigned*)(lds + (32 * wave + 4 * q) * 256), 16, 0, 0);
            __builtin_amdgcn_global_load_lds((const unsigned*)(Zv + go), (LAS unsigned*)(lds + 65536 + (32 * wave + 4 * q) * 256), 16, 0, 0);
        }
        const int q0 = i0 + 16 * wave;
        bf16x8 qf[4];
#pragma unroll
        for (int s = 0; s < 4; ++s) qf[s] = *(const bf16x8*)(Zq + (rowbase + ((size_t)(q0 + c) << sh)) * DIN + 32 * s + 8 * g4);
        __syncthreads();
        const int w16 = 16 * wave;
        f32x4 sa[9];
#pragma unroll
        for (int kt = 0; kt < 9; ++kt) { f32x4 acc = (f32x4){0.f, 0.f, 0.f, 0.f};
#pragma unroll
            for (int s = 0; s < 4; ++s) { const bf16x8 kf = *(const LAS bf16x8*)(lds + off_b(w16 + 16 * kt + c, 4 * s + g4));
                acc = __builtin_amdgcn_mfma_f32_16x16x32_bf16(kf, qf[s], acc, 0, 0, 0); }
            sa[kt] = acc; }
        const LAS float* tb = tab + head * 192 + 95 - 64 - c;
        const bool edge = (q0 < 64) || (q0 + 80 > L);
#pragma unroll
        for (int kt = 0; kt < 9; ++kt) { const f32x4 bv = *(const LAS f32x4*)(tb + 16 * kt + 4 * g4); sa[kt] = sa[kt] + bv; }
        if (edge) {
#pragma unroll
            for (int kt = 0; kt < 9; ++kt)
#pragma unroll
                for (int j = 0; j < 4; ++j) { const int fi = q0 - 64 + 16 * kt + 4 * g4 + j; if (fi < 0 || fi >= L) sa[kt][j] = -1e30f; }
        }
        float m = -1e30f;
#pragma unroll
        for (int kt = 0; kt < 9; ++kt) m = fmaxf(fmaxf(m, fmaxf(sa[kt][0], sa[kt][1])), fmaxf(sa[kt][2], sa[kt][3]));
        m = fmaxf(m, __shfl_xor(m, 16)); m = fmaxf(m, __shfl_xor(m, 32));
        float sum = 0.f;
#pragma unroll
        for (int kt = 0; kt < 9; ++kt)
#pragma unroll
            for (int j = 0; j < 4; ++j) { const float p = __builtin_amdgcn_exp2f(sa[kt][j] - m); sa[kt][j] = p; sum += p; }
        sum += __shfl_xor(sum, 16); sum += __shfl_xor(sum, 32);
        bf16x8 pf[5];
#pragma unroll
        for (int ks = 0; ks < 5; ++ks) { const f32x4 p0 = sa[2 * ks]; const f32x4 p1 = ks < 4 ? sa[ks < 4 ? 2 * ks + 1 : 8] : (f32x4){0.f, 0.f, 0.f, 0.f};
            u32x4 w; w.x = pk2(p0[0], p0[1]); w.y = pk2(p0[2], p0[3]); w.z = pk2(p1[0], p1[1]); w.w = pk2(p1[2], p1[3]);
            pf[ks] = __builtin_bit_cast(bf16x8, w); }
        f32x4 oa[8];
#pragma unroll
        for (int cc = 0; cc < 8; ++cc) oa[cc] = (f32x4){0.f, 0.f, 0.f, 0.f};
        LAS const unsigned char* vimg = lds + 65536;
#pragma unroll
        for (int ks = 0; ks < 5; ++ks) {
            const int r0 = w16 + 32 * ks + 4 * g4 + tq; int r1 = r0 + 16; r1 = r1 > 255 ? 255 : r1;
#pragma unroll
            for (int cc = 0; cc < 8; ++cc) {
                const s16x4 lo = ldtr(vimg + off_b(r0, 2 * cc + (tp >> 1)) + 8 * (tp & 1));
                const s16x4 hi = ldtr(vimg + off_b(r1, 2 * cc + (tp >> 1)) + 8 * (tp & 1));
                const bf16x8 vf = (bf16x8){lo[0], lo[1], lo[2], lo[3], hi[0], hi[1], hi[2], hi[3]};
                oa[cc] = __builtin_amdgcn_mfma_f32_16x16x32_bf16(vf, pf[ks], oa[cc], 0, 0, 0);
            }
        }
        {
            const float inv = 1.0f / sum;
            const size_t row = rowbase + ((size_t)(q0 + c) << sh);
            bf16_t* op = OG + ((size_t)grp * CH + row) * AW + h * 128 + 4 * g4;
#pragma unroll
            for (int cc = 0; cc < 8; ++cc) { const f32x4 o = oa[cc] * inv; u32x2 w; w.x = pk2(o[0], o[1]); w.y = pk2(o[2], o[3]); *(u32x2*)(op + 16 * cc) = w; }
            if (g4 == 0) LSE[((size_t)grp * CH + row) * 4 + h] = m + log2f(sum);
        }
        __syncthreads();
    }
}
__device__ __forceinline__ void phase_combine(const bf16_t* OG, const float* LSE, bf16_t* ATT, int tid, int G) {
    for (size_t idx = (size_t)blockIdx.x * 512 + tid; idx < (size_t)CH * 64; idx += (size_t)G * 512) {
        const size_t row = idx >> 6; const int ck = (int)(idx & 63), h = ck >> 4;
        const float l0 = LSE[(row) * 4 + h], l1 = LSE[((size_t)CH + row) * 4 + h], l2 = LSE[((size_t)2 * CH + row) * 4 + h];
        const float M = fmaxf(l0, fmaxf(l1, l2));
        float w0 = __builtin_amdgcn_exp2f(l0 - M), w1 = __builtin_amdgcn_exp2f(l1 - M), w2 = __builtin_amdgcn_exp2f(l2 - M);
        const float inv = 1.0f / (w0 + w1 + w2); w0 *= inv; w1 *= inv; w2 *= inv;
        const u32x4 a = *(const u32x4*)(OG + row * AW + ck * 8), b = *(const u32x4*)(OG + ((size_t)CH + row) * AW + ck * 8), d = *(const u32x4*)(OG + ((size_t)2 * CH + row) * AW + ck * 8);
        u32x4 o;
#pragma unroll
        for (int e = 0; e < 4; ++e) { const float lo = w0 * bflo(a[e]) + w1 * bflo(b[e]) + w2 * bflo(d[e]), hi = w0 * bfhi(a[e]) + w1 * bfhi(b[e]) + w2 * bfhi(d[e]); o[e] = pk2(lo, hi); }
        *(u32x4*)(ATT + row * AW + ck * 8) = o;
    }
}

constexpr int LRU_RAW = 0, LRU_RAWP = 272, LRU_XC = 18432, LRU_KC = 36864;

#define LRU_SCAN_STEP(DIR, N) \
    "v_fmac_f32_dpp %4, %4, %0 " DIR ":" #N " row_mask:0xf bank_mask:0xf\n\t" "v_fmac_f32_dpp %5, %5, %1 " DIR ":" #N " row_mask:0xf bank_mask:0xf\n\t" \
    "v_fmac_f32_dpp %6, %6, %2 " DIR ":" #N " row_mask:0xf bank_mask:0xf\n\t" "v_fmac_f32_dpp %7, %7, %3 " DIR ":" #N " row_mask:0xf bank_mask:0xf\n\t" \
    "v_mul_f32_dpp %0, %0, %0 " DIR ":" #N " row_mask:0xf bank_mask:0xf\n\t" "v_mul_f32_dpp %1, %1, %1 " DIR ":" #N " row_mask:0xf bank_mask:0xf\n\t" \
    "v_mul_f32_dpp %2, %2, %2 " DIR ":" #N " row_mask:0xf bank_mask:0xf\n\t" "v_mul_f32_dpp %3, %3, %3 " DIR ":" #N " row_mask:0xf bank_mask:0xf\n\t"
__device__ __forceinline__ void lru_scan4_fwd(f32x4& a, f32x4& h) {
    float a0 = a[0], a1 = a[1], a2 = a[2], a3 = a[3], h0 = h[0], h1 = h[1], h2 = h[2], h3 = h[3];
    asm volatile("s_nop 1\n\t" LRU_SCAN_STEP("row_shr", 1) LRU_SCAN_STEP("row_shr", 2) LRU_SCAN_STEP("row_shr", 4) LRU_SCAN_STEP("row_shr", 8) "s_nop 1"
                 : "+v"(a0), "+v"(a1), "+v"(a2), "+v"(a3), "+v"(h0), "+v"(h1), "+v"(h2), "+v"(h3));
    a = (f32x4){a0, a1, a2, a3}; h = (f32x4){h0, h1, h2, h3};
}
__device__ __forceinline__ void lru_scan4_bwd(f32x4& a, f32x4& h) {
    float a0 = a[0], a1 = a[1], a2 = a[2], a3 = a[3], h0 = h[0], h1 = h[1], h2 = h[2], h3 = h[3];
    asm volatile("s_nop 1\n\t" LRU_SCAN_STEP("row_shl", 1) LRU_SCAN_STEP("row_shl", 2) LRU_SCAN_STEP("row_shl", 4) LRU_SCAN_STEP("row_shl", 8) "s_nop 1"
                 : "+v"(a0), "+v"(a1), "+v"(a2), "+v"(a3), "+v"(h0), "+v"(h1), "+v"(h2), "+v"(h3));
    a = (f32x4){a0, a1, a2, a3}; h = (f32x4){h0, h1, h2, h3};
}
template <int PASS> __device__ __forceinline__ void phase_lru(LAS unsigned char* lds, const bf16_t* Z, const bf16_t* WL, float* LSUM, const float* LCAR, bf16_t* RNN,
                                                              int S, int tid, int lane, int wave, int G) {
    const int c = lane & 15, g4 = lane >> 4;
    const float* conv_w = ARGP(5); const float* conv_b = ARGP(6); const float* lba = ARGP(8); const float* lbx = ARGP(10); const float* lam = ARGP(11);
    for (int item = blockIdx.x; item < 12 * 64; item += G) {
        const int n = item >> 6, run = item & 63;
        const int ch0 = n * 128 + wave * 16 + 4 * g4;
        bf16x8 wf[4][4];
#pragma unroll
        for (int q = 0; q < 4; ++q)
#pragma unroll
            for (int s = 0; s < 4; ++s) wf[q][s] = *(const bf16x8*)(WL + ((size_t)((n * 4 + q) * 128 + wave * 16 + c)) * 128 + 32 * s + 8 * g4);
        LAS f32x4* kc = (LAS f32x4*)(lds + LRU_KC + wave * 11264);
#pragma unroll
        for (int k = 0; k < 4; ++k) kc[(6 + k) * 64 + lane] = *(const f32x4*)(conv_w + k * LW + ch0);
        kc[10 * 64 + lane] = *(const f32x4*)(conv_b + ch0);
#pragma unroll
        for (int d = 0; d < 2; ++d) { kc[(3 * d + 0) * 64 + lane] = *(const f32x4*)(lba + d * LW + ch0) * (-LOG2E); kc[(3 * d + 1) * 64 + lane] = *(const f32x4*)(lbx + d * LW + ch0) * (-LOG2E);
            const f32x4 lv = *(const f32x4*)(lam + d * LW + ch0); f32x4 sp;
#pragma unroll
            for (int j = 0; j < 4; ++j) sp[j] = -8.0f * LOG2E * log1pf(expf(-lv[j]));
            kc[(3 * d + 2) * 64 + lane] = sp; }
#define LRU_BAR() do { asm volatile("s_waitcnt lgkmcnt(0)" ::: "memory"); __builtin_amdgcn_s_barrier(); asm volatile("" ::: "memory"); } while (0)
        u32x4 rawr[3];
#define LRU_LOAD_RAW(SEG) { const int t0_ = (SEG) * 64, spos_ = t0_ & (S - 1); \
            _Pragma("unroll") for (int i = 0; i < 3; ++i) { const int idx = tid + 512 * i, rr = idx >> 4, chk = idx & 15, sp_ = spos_ - 2 + rr; \
                rawr[i] = (u32x4){0u, 0u, 0u, 0u}; \
                if (idx < 67 * 16 && sp_ >= 0 && sp_ < S) rawr[i] = *(const u32x4*)(Z + (size_t)(t0_ - 2 + rr) * DIN + C_RX + n * 128 + 8 * chk); } }
        LRU_LOAD_RAW(run * 4)
        for (int sg = 0; sg < 4; ++sg) {
            const int seg = run * 4 + sg, t0 = seg * 64;
#pragma unroll
            for (int i = 0; i < 3; ++i) { const int idx = tid + 512 * i; if (idx < 67 * 16) *(LAS u32x4*)(lds + LRU_RAW + (idx >> 4) * LRU_RAWP + 16 * (idx & 15)) = rawr[i]; }
            u32x2 ryr[4]; f32x4 car[2];
            if (PASS == 1) {
#pragma unroll
                for (int t = 0; t < 4; ++t) ryr[t] = *(const u32x2*)(Z + (size_t)(t0 + 16 * t + c) * DIN + C_RY + ch0);
                car[0] = *(const f32x4*)(LCAR + (size_t)(seg * 2 + 0) * LW + ch0); car[1] = *(const f32x4*)(LCAR + (size_t)(seg * 2 + 1) * LW + ch0);
            }
            LRU_BAR();
            f32x4 cw[4], cb;
#pragma unroll
            for (int k = 0; k < 4; ++k) cw[k] = kc[(6 + k) * 64 + lane];
            cb = kc[10 * 64 + lane];
            f32x4 xc[4];
#pragma unroll
            for (int t = 0; t < 4; ++t) { f32x4 acc = cb;
#pragma unroll
                for (int k = 0; k < 4; ++k) { const u32x2 rw = *(const LAS u32x2*)(lds + LRU_RAW + (16 * t + c + k) * LRU_RAWP + (wave * 16 + 4 * g4) * 2);
                    acc = acc + (f32x4){bflo(rw.x), bfhi(rw.x), bflo(rw.y), bfhi(rw.y)} * cw[k]; }
                xc[t] = acc;
                u32x2 w; w.x = pk2(acc[0], acc[1]); w.y = pk2(acc[2], acc[3]);
                *(LAS u32x2*)(lds + LRU_XC + off_b(16 * t + c, 2 * wave + (g4 >> 1)) + 8 * (g4 & 1)) = w; }
            LRU_BAR();
            if (sg + 1 < 4) LRU_LOAD_RAW(seg + 1)
            f32x4 hf[4];
            {
                f32x4 Hc = (f32x4){0.f, 0.f, 0.f, 0.f}, Ac = (f32x4){1.f, 1.f, 1.f, 1.f};
                if (PASS == 1) Hc = car[0];
#pragma unroll
                for (int t = 0; t < 4; ++t) {
                    f32x4 gr = (f32x4){0.f, 0.f, 0.f, 0.f}, gi = gr;
#pragma unroll
                    for (int s = 0; s < 4; ++s) { const bf16x8 bfr = *(const LAS bf16x8*)(lds + LRU_XC + off_b(16 * t + c, 4 * s + g4));
                        gr = __builtin_amdgcn_mfma_f32_16x16x32_bf16(wf[0][s], bfr, gr, 0, 0, 0); gi = __builtin_amdgcn_mfma_f32_16x16x32_bf16(wf[1][s], bfr, gi, 0, 0, 0); }
                    const f32x4 kba = kc[0 * 64 + lane], kbx = kc[1 * 64 + lane], ksp = kc[2 * 64 + lane];
                    f32x4 av, hv;
#pragma unroll
                    for (int j = 0; j < 4; ++j) {
                        const float rg = __builtin_amdgcn_rcpf(1.0f + __builtin_amdgcn_exp2f(fmaf(gr[j], -LOG2E, kba[j])));
                        const float ig = __builtin_amdgcn_rcpf(1.0f + __builtin_amdgcn_exp2f(fmaf(gi[j], -LOG2E, kbx[j])));
                        const float a_ = __builtin_amdgcn_exp2f(rg * ksp[j]);
                        av[j] = a_; hv[j] = __builtin_amdgcn_sqrtf(fmaf(-a_, a_, 1.0f)) * (ig * xc[t][j]);
                    }
                    lru_scan4_fwd(av, hv);
#pragma unroll
                    for (int j = 0; j < 4; ++j) {
                        const float hfull = fmaf(av[j], Hc[j], hv[j]);
                        if (PASS == 1) hf[t][j] = hfull;
                        Hc[j] = __shfl(hfull, (lane & 48) | 15);
                        if (PASS == 0) Ac[j] *= __shfl(av[j], (lane & 48) | 15);
                    }
                    __builtin_amdgcn_sched_barrier(0);
                }
                if (PASS == 0 && c == 0) {
#pragma unroll
                    for (int j = 0; j < 4; ++j) { float* sp = LSUM + ((size_t)(seg * 2 + 0) * LW + ch0 + j) * 2; sp[0] = Ac[j]; sp[1] = Hc[j]; }
                }
            }
            {
                f32x4 Hc = (f32x4){0.f, 0.f, 0.f, 0.f}, Ac = (f32x4){1.f, 1.f, 1.f, 1.f};
                if (PASS == 1) Hc = car[1];
#pragma unroll
                for (int tt = 0; tt < 4; ++tt) { const int t = 3 - tt;
                    f32x4 gr = (f32x4){0.f, 0.f, 0.f, 0.f}, gi = gr;
#pragma unroll
                    for (int s = 0; s < 4; ++s) { const bf16x8 bfr = *(const LAS bf16x8*)(lds + LRU_XC + off_b(16 * t + c, 4 * s + g4));
                        gr = __builtin_amdgcn_mfma_f32_16x16x32_bf16(wf[2][s], bfr, gr, 0, 0, 0); gi = __builtin_amdgcn_mfma_f32_16x16x32_bf16(wf[3][s], bfr, gi, 0, 0, 0); }
                    f32x4 ov;
                    const f32x4 kba = kc[3 * 64 + lane], kbx = kc[4 * 64 + lane], ksp = kc[5 * 64 + lane];
                    f32x4 av, hv;
#pragma unroll
                    for (int j = 0; j < 4; ++j) {
                        const float rg = __builtin_amdgcn_rcpf(1.0f + __builtin_amdgcn_exp2f(fmaf(gr[j], -LOG2E, kba[j])));
                        const float ig = __builtin_amdgcn_rcpf(1.0f + __builtin_amdgcn_exp2f(fmaf(gi[j], -LOG2E, kbx[j])));
                        const float a_ = __builtin_amdgcn_exp2f(rg * ksp[j]);
                        av[j] = a_; hv[j] = __builtin_amdgcn_sqrtf(fmaf(-a_, a_, 1.0f)) * (ig * xc[t][j]);
                    }
                    lru_scan4_bwd(av, hv);
#pragma unroll
                    for (int j = 0; j < 4; ++j) {
                        const float hfull = fmaf(av[j], Hc[j], hv[j]);
                        Hc[j] = __shfl(hfull, lane & 48);
                        if (PASS == 0) Ac[j] *= __shfl(av[j], lane & 48);
                        if (PASS == 1) { const unsigned rw = j < 2 ? ryr[t].x : ryr[t].y; const float y = (j & 1) ? bfhi(rw) : bflo(rw);
                            const float ge = y * __builtin_amdgcn_rcpf(1.0f + __builtin_amdgcn_exp2f((-2.3022082f * y) * fmaf(0.044715f * y, y, 1.0f)));
                            ov[j] = (hf[t][j] + hfull) * ge; }
                    }
                    if (PASS == 1) { u32x2 w; w.x = pk2(ov[0], ov[1]); w.y = pk2(ov[2], ov[3]); *(u32x2*)(RNN + (size_t)(t0 + 16 * t + c) * LW + ch0) = w; }
                    __builtin_amdgcn_sched_barrier(0);
                }
                if (PASS == 0 && c == 0) {
#pragma unroll
                    for (int j = 0; j < 4; ++j) { float* sp = LSUM + ((size_t)(seg * 2 + 1) * LW + ch0 + j) * 2; sp[0] = Ac[j]; sp[1] = Hc[j]; }
                }
            }
        }
#undef LRU_LOAD_RAW
#undef LRU_BAR
        __syncthreads();
    }
}
__device__ __forceinline__ void phase_lru_carry(const float* LSUM, float* LCAR, int S, int tid, int G) {
    const int nseq = CH / S, nseg = S / 64;
    for (int idx = blockIdx.x * 512 + tid; idx < nseq * 2 * LW; idx += G * 512) {
        const int ch = idx % LW, dir = (idx / LW) & 1, b = idx / (2 * LW);
        float H = 0.f;
        for (int i0 = 0; i0 < nseg; i0 += 8) {
            float A[8], h[8];
#pragma unroll
            for (int u = 0; u < 8; ++u) { const int i = i0 + u, s = dir ? nseg - 1 - i : i; const size_t o = (size_t)((b * nseg + s) * 2 + dir) * LW + ch;
                const float2 v = *(const float2*)(LSUM + o * 2); A[u] = v.x; h[u] = v.y; }
#pragma unroll
            for (int u = 0; u < 8; ++u) { const int i = i0 + u, s = dir ? nseg - 1 - i : i; const size_t o = (size_t)((b * nseg + s) * 2 + dir) * LW + ch;
                LCAR[o] = H; H = fmaf(A[u], H, h[u]); }
        }
    }
}

#ifndef REP_MASK
#define REP_MASK 0
#endif
#ifndef ONLY_K
#define EN(k) true
#else
#define EN(k) ((k) == ONLY_K)
#endif
__global__ void __launch_bounds__(512, 2) fwd_kernel(Args args) {
    extern __shared__ __attribute__((aligned(16))) unsigned char lds_raw[];
    LAS unsigned char* lds = (LAS unsigned char*)lds_raw;
    {
        LAS unsigned long long* pt = (LAS unsigned long long*)(lds + 131072);
        if (threadIdx.x == 0) {
#pragma unroll
            for (int i = 0; i < 19; ++i) pt[i] = (unsigned long long)args.in[i];
            pt[19] = (unsigned long long)args.out; pt[20] = (unsigned long long)args.ws;
        }
        if (threadIdx.x == 32) { ((LAS unsigned*)(lds + 131072 + 512))[0] = 0u; ((LAS unsigned*)(lds + 131072 + 512))[1] = 0u; }
        __syncthreads();
    }
    cg::grid_group grid = cg::this_grid();
    const bool ph_lo_neg = args.ph_lo < 0;
    XcdBarrier xbar = xcd_barrier_post((unsigned*)(GAS unsigned*)args.ws + 1024, (volatile LAS unsigned*)(lds + 131072 + 512));
    bool first_sync = (ph_lo_neg);
#define GRID_BAR() do { __syncthreads(); if (first_sync) { grid.sync(); first_sync = false; } else xcd_barrier(xbar); } while (0)

    const int ph_hi = args.ph_hi;
    for (int q = 2 * args.ph_lo; q < 2 * ph_hi; ++q) {
        const int p = q >> 1;
        if (REP_MASK == 0 && (q & 1)) continue;
        if (REP_MASK != 0 && (q & 1) && !((REP_MASK >> (p == 0 ? 9 : (p - 1) % NPH)) & 1)) { if (p + 1 < ph_hi) GRID_BAR(); continue; }
        int tid = threadIdx.x; asm volatile("" : "+v"(tid));
        const int lane = tid & 63, wave = __builtin_amdgcn_readfirstlane(tid >> 6);
        const int G = gridDim.x, gw = blockIdx.x * 8 + wave, NGW = G * 8;
        unsigned char* ws = (unsigned char*)(GAS unsigned char*)ldsptr(lds, 20);
        bf16_t* const WIN = (bf16_t*)(ws + WS_WIN); bf16_t* const WAO = (bf16_t*)(ws + WS_WAO); bf16_t* const WRO = (bf16_t*)(ws + WS_WRO); bf16_t* const WOUT = (bf16_t*)(ws + WS_WOUT);
        bf16_t* const W1 = (bf16_t*)(ws + WS_W1); bf16_t* const W2 = (bf16_t*)(ws + WS_W2); bf16_t* const WL = (bf16_t*)(ws + WS_WL);
        float* const SS = (float*)(ws + WS_SS); float* const LSUM = (float*)(ws + WS_LSUM); float* const LCAR = (float*)(ws + WS_LCAR); float* const LSE = (float*)(ws + WS_LSE);
        bf16_t* const XN = (bf16_t*)(ws + WS_XN); bf16_t* const ATT = (bf16_t*)(ws + WS_ATT); bf16_t* const RNN = (bf16_t*)(ws + WS_RNN); bf16_t* const OG = (bf16_t*)(ws + WS_OG);
        bf16_t* const MG = (bf16_t*)(ws + WS_MG); bf16_t* const X2B = (bf16_t*)(ws + WS_X2B); unsigned char* const G8 = ws + WS_G8; bf16_t* const Z = (bf16_t*)(ws + WS_Z); bf16_t* const HB = (bf16_t*)(ws + WS_Z);
        if (EN(9) && p == 0) {
            phase_weights(lds, ws, 0, gw, NGW, wave, lane); phase_weights(lds, ws, 1, gw, NGW, wave, lane);
            phase_xnorm(ARGP(0), ARGP(3), XN, gw, NGW, lane);
        } else {
            const int ck = (p - 1) / NPH, k = (p - 1) % NPH;
            const int S = ck < 2 ? 2048 : 4096;
            const float* xin = ck < 2 ? ARGP(0) + (size_t)ck * CH * DM : ARGP(1);
            float* out = (float*)ARGP(19) + (size_t)ck * CH * DM;
            if (EN(0) && k == 0) {
                pg8::Gemm g{XN, WIN, CH, DIN, DM}; pg8::StaticOrder So; So.init(CH, DIN, G, (int)blockIdx.x);
                pg8::EpiZ E{Z, G8};
                pg8::gemm_phase<pg8::EpiZ, pg8::StaticOrder, true, true>(lds, g, So, E);
                if ((int)blockIdx.x >= G / 2) { const int dgw = ((int)blockIdx.x - G / 2) * 8 + wave, DNGW = (G - G / 2) * 8;
                    if (ck > 0) phase_final_norm((float*)ARGP(19) + (size_t)(ck - 1) * CH * DM, X2B, SS, ARGP(18), dgw, DNGW, lane); }
            } else if (EN(1) && k == 1) {
#ifndef NO_LRU0
                phase_lru<0>(lds, Z, WL, LSUM, LCAR, RNN, S, tid, lane, wave, G);
                __syncthreads();
#endif
#ifndef NO_ATTN
                phase_attn(lds, Z, ARGP(2), OG, LSE, S, tid, lane, wave, G);
#endif
            } else if (EN(2) && k == 2) {
                phase_lru_carry(LSUM, LCAR, S, tid, G);
                phase_combine(OG, LSE, ATT, tid, G);
            } else if (EN(3) && k == 3) {
                phase_lru<1>(lds, Z, WL, LSUM, LCAR, RNN, S, tid, lane, wave, G);
            } else if (EN(4) && k == 4) {
                { pg8::Gemm g{ATT, WAO, CH, DM, AW}; pg8::StaticOrder So; So.init(CH, DM, G, (int)blockIdx.x);
                  pg8::EpiGate<false> E{G8, 0, (pg8::u32x4*)X2B, MG};
                  pg8::gemm_phase<pg8::EpiGate<false>, pg8::StaticOrder, true, true>(lds, g, So, E); }
                { pg8::Gemm g{RNN, WRO, CH, DM, LW}; pg8::StaticOrder So; So.init(CH, DM, G, (int)blockIdx.x);
                  pg8::EpiGate<true> E{G8, 8, (pg8::u32x4*)X2B, MG};
                  pg8::gemm_phase<pg8::EpiGate<true>, pg8::StaticOrder, true, true>(lds, g, So, E); }
            } else if (EN(5) && k == 5) {
                pg8::Gemm g{MG, WOUT, CH, DM, DM}; pg8::StaticOrder So; So.init(CH, DM, G, (int)blockIdx.x);
                pg8::EpiX1 E{xin, XN, SS};
                pg8::gemm_phase<pg8::EpiX1, pg8::StaticOrder, true, true>(lds, g, So, E);
            } else if (EN(6) && k == 6) {
                pg8::Gemm g{XN, W1, CH, DFF, DM}; pg8::StaticOrder So; So.init(CH, DFF, G, (int)blockIdx.x);
                pg8::EpiMlpUp E{SS, HB};
                pg8::gemm_phase<pg8::EpiMlpUp, pg8::StaticOrder, true, true>(lds, g, So, E);
            } else if (EN(7) && k == 7) {
                pg8::Gemm g{HB, W2, CH, DM, DFF}; pg8::StaticOrder So; So.init(CH, DM, G, (int)blockIdx.x);
                pg8::EpiX2 E{XN, X2B, SS};
                pg8::gemm_phase<pg8::EpiX2, pg8::StaticOrder, true, true>(lds, g, So, E);
            } else if (EN(8)) {
                if (ck + 1 < NCH) { const float* xn = (ck + 1) < 2 ? ARGP(0) + (size_t)(ck + 1) * CH * DM : ARGP(1); phase_xnorm(xn, ARGP(3), XN, gw, NGW, lane); }
                else phase_final_norm(out, X2B, SS, ARGP(18), gw, NGW, lane);
            }
        }
        if (REP_MASK != 0 && !(q & 1)) { __syncthreads(); continue; }
        if (p + 1 < ph_hi) GRID_BAR();
    }
}

extern "C" void kernel_launch(void* const* d_in, const int* in_sizes, int n_in, void* d_out, int out_size, void* d_ws, size_t ws_size, hipStream_t stream) {
    static int grid = 0;
    if (grid == 0) {
        if (n_in != 19 || ws_size < WS_END) { fprintf(stderr, "kernel_launch: unexpected n_in %d / ws_size %zu\n", n_in, ws_size); grid = -1; return; }
        int dev = 0, cus = 0, per_cu = 0;
        hipGetDevice(&dev); hipDeviceGetAttribute(&cus, hipDeviceAttributeMultiprocessorCount, dev);
        if (hipFuncSetAttribute((const void*)fwd_kernel, hipFuncAttributeMaxDynamicSharedMemorySize, LDS_BYTES) != hipSuccess) { fprintf(stderr, "kernel_launch: hipFuncSetAttribute failed\n"); grid = -1; return; }
        hipOccupancyMaxActiveBlocksPerMultiprocessor(&per_cu, (const void*)fwd_kernel, 512, LDS_BYTES);
        (void)hipGetLastError();
        if (per_cu < 1) fprintf(stderr, "kernel_launch: occupancy query says %d blocks per CU\n", per_cu);
        grid = cus > 0 ? cus : 256;
    }
    if (grid < 0) return;
    if (hipMemsetAsync(d_ws, 0, 65536, stream) != hipSuccess) { fprintf(stderr, "kernel_launch: hipMemsetAsync failed\n"); return; }
    Args a{};
    for (int i = 0; i < 19; ++i) a.in[i] = (const float*)d_in[i];
    a.out = (float*)d_out; a.ws = (unsigned char*)d_ws;
#if MK_MULTI
    for (int p = 0; p < NPHASES; ++p) { a.ph_lo = p; a.ph_hi = p + 1; hipLaunchKernelGGL(fwd_kernel, dim3(grid), dim3(512), LDS_BYTES, stream, a); }
#else
    a.ph_lo = 0; a.ph_hi = NPHASES;
    void* kargs[] = {&a};
    hipError_t e = hipLaunchCooperativeKernel((const void*)fwd_kernel, dim3(grid), dim3(512), kargs, LDS_BYTES, stream);
    if (e != hipSuccess) fprintf(stderr, "kernel_launch: cooperative launch failed: %s (grid %d)\n", hipGetErrorString(e), grid);
#endif
}
```
